# Optimizing an MI355X kernel written in HIP

```python
import math
import jax, jax.numpy as jnp
from jax import lax
import numpy as np

D_MODEL = 1024
BATCH = 16
SEQ = 4096
DEPTH = 4

GRID_W = 64
CTX_LEN = 256
N_MIXERS = 3
D_FF = 4 * D_MODEL
RMS_EPS = 1e-6
ROPE_BASE = 10000.0
Q_BLOCK = 128
FOURIER_GROUPS = 4
DIFF_HEADS = D_MODEL // 128
DIFF_HEAD_DIM = D_MODEL // (2 * DIFF_HEADS)
DIFF_V_DIM = 2 * DIFF_HEAD_DIM
MLA_HEADS = 16
MLA_NOPE_DIM = 64
MLA_ROPE_DIM = 32
MLA_V_DIM = 64
MLA_Q_RANK = 256
MLA_KV_RANK = 128
MLA_DOWN = MLA_Q_RANK + MLA_KV_RANK + MLA_ROPE_DIM
N_FOURIER = (DEPTH + 2) // 3
N_DIFF = (DEPTH + 1) // 3
N_MLA = DEPTH // 3

kernel_name = "hybrid_fourier_diffattn_mla_dit"


def rms_norm(x, g, eps=RMS_EPS):
    x32 = x.astype(jnp.float32)
    y = x32 * lax.rsqrt(jnp.mean(x32 * x32, axis=-1, keepdims=True) + eps)
    return y.astype(x.dtype) * g


def modulate(x, g, shift, scale):
    return rms_norm(x, g) * (1 + scale) + shift


def axial_rope_tables(rows, dim):
    n_freq = dim // 4
    inv_freq = ROPE_BASE ** (-jnp.arange(n_freq, dtype=jnp.float32) / n_freq)
    t = jnp.arange(rows * GRID_W)
    row = (t // GRID_W).astype(jnp.float32)
    col = (t % GRID_W).astype(jnp.float32)
    ang = jnp.stack([row[:, None] * inv_freq, col[:, None] * inv_freq], axis=1)
    return jnp.cos(ang), jnp.sin(ang)


def apply_axial_rope(x, cos, sin):
    shp = x.shape
    n_freq = shp[-1] // 4
    xs = x.reshape(shp[:-1] + (2, 2, n_freq))
    x1, x2 = xs[..., 0, :], xs[..., 1, :]
    cb = cos[None, :, None].astype(x.dtype)
    sb = sin[None, :, None].astype(x.dtype)
    out = jnp.stack([x1 * cb - x2 * sb, x2 * cb + x1 * sb], axis=-2)
    return out.reshape(shp)


def sweep_query_blocks(fn, *qs):
    b, s = qs[0].shape[:2]
    nb = s // Q_BLOCK
    blocks = tuple(jnp.moveaxis(q.reshape((b, nb, Q_BLOCK) + q.shape[2:]), 1, 0) for q in qs)
    out = lax.map(lambda blk: fn(*blk), blocks)
    return jnp.moveaxis(out, 0, 1).reshape((b, s) + out.shape[3:])


def sq_relu_mlp(h, w1, w2):
    return jnp.square(jax.nn.relu(h @ w1)) @ w2


def fourier_mixer(h, w, bias):
    b, s, d = h.shape
    hg = h.astype(jnp.float32).reshape(b, s, FOURIER_GROUPS, d // FOURIER_GROUPS)
    f = jnp.fft.fft2(hg, axes=(1, 3), norm="ortho").real
    return f.reshape(b, s, d).astype(h.dtype) @ w + bias


def diff_project(h, w_qkv, rope):
    b, s, _ = h.shape
    q, k, v = jnp.split(h @ w_qkv, 3, axis=-1)
    q = q.reshape(b, s, 2 * DIFF_HEADS, DIFF_HEAD_DIM)
    k = k.reshape(b, s, 2 * DIFF_HEADS, DIFF_HEAD_DIM)
    if rope is not None:
        q = apply_axial_rope(q, *rope)
        k = apply_axial_rope(k, *rope)
    q = q.reshape(b, s, DIFF_HEADS, 2, DIFF_HEAD_DIM)
    k = k.reshape(b, s, DIFF_HEADS, 2, DIFF_HEAD_DIM)
    v = v.reshape(b, s, DIFF_HEADS, DIFF_V_DIM)
    return q[..., 0, :], q[..., 1, :], k[..., 0, :], k[..., 1, :], v


def diff_attend(q1, q2, k1, k2, v, lam):
    scale = DIFF_HEAD_DIM ** -0.5
    s1 = jnp.einsum("bqhd,bkhd->bhqk", q1, k1).astype(jnp.float32) * scale
    s2 = jnp.einsum("bqhd,bkhd->bhqk", q2, k2).astype(jnp.float32) * scale
    p = jax.nn.softmax(s1, axis=-1) - lam * jax.nn.softmax(s2, axis=-1)
    return jnp.einsum("bhqk,bkhe->bqhe", p.astype(v.dtype), v)


def diff_attention_mixer(h_lat, h_ctx, w_qkv, lq1, lk1, lq2, lk2, subln_g, w_o, layer_idx, rope, with_ctx):
    lam_init = 0.8 - 0.6 * math.exp(-0.3 * layer_idx)
    lam = (jnp.exp(jnp.sum(lq1.astype(jnp.float32) * lk1.astype(jnp.float32)))
           - jnp.exp(jnp.sum(lq2.astype(jnp.float32) * lk2.astype(jnp.float32))) + lam_init)
    q1l, q2l, k1l, k2l, vl = diff_project(h_lat, w_qkv, rope)
    q1c, q2c, k1c, k2c, vc = diff_project(h_ctx, w_qkv, None)
    k1a = jnp.concatenate([k1c, k1l], axis=1)
    k2a = jnp.concatenate([k2c, k2l], axis=1)
    va = jnp.concatenate([vc, vl], axis=1)

    def finish(o):
        b, s = o.shape[:2]
        return (rms_norm(o, subln_g) * (1 - lam_init)).reshape(b, s, D_MODEL) @ w_o

    o_lat = sweep_query_blocks(lambda a, bq: diff_attend(a, bq, k1a, k2a, va, lam), q1l, q2l)
    y_lat = finish(o_lat)
    y_ctx = finish(diff_attend(q1c, q2c, k1c, k2c, vc, lam)) if with_ctx else None
    return y_lat, y_ctx


def mla_project(h, w_down, q_norm_g, kv_norm_g, w_uq, w_ukv, rope):
    b, s, _ = h.shape
    cq, ckv, k_rope = jnp.split(h @ w_down, [MLA_Q_RANK, MLA_Q_RANK + MLA_KV_RANK], axis=-1)
    q = (rms_norm(cq, q_norm_g) @ w_uq).reshape(b, s, MLA_HEADS, MLA_NOPE_DIM + MLA_ROPE_DIM)
    q_nope, q_rope = jnp.split(q, [MLA_NOPE_DIM], axis=-1)
    kv = (rms_norm(ckv, kv_norm_g) @ w_ukv).reshape(b, s, MLA_HEADS, MLA_NOPE_DIM + MLA_V_DIM)
    k_nope, v = jnp.split(kv, [MLA_NOPE_DIM], axis=-1)
    k_rope = k_rope[:, :, None, :]
    if rope is not None:
        q_rope = apply_axial_rope(q_rope, *rope)
        k_rope = apply_axial_rope(k_rope, *rope)
    return q_nope, q_rope, k_nope, k_rope[:, :, 0], v


def mla_attend(q_nope, q_rope, k_nope, k_rope, v):
    scale = (MLA_NOPE_DIM + MLA_ROPE_DIM) ** -0.5
    s = (jnp.einsum("bqhd,bkhd->bhqk", q_nope, k_nope)
         + jnp.einsum("bqhr,bkr->bhqk", q_rope, k_rope)).astype(jnp.float32) * scale
    p = jax.nn.softmax(s, axis=-1)
    return jnp.einsum("bhqk,bkhe->bqhe", p.astype(v.dtype), v)


def mla_mixer(h_lat, h_ctx, w_down, q_norm_g, kv_norm_g, w_uq, w_ukv, w_o, rope, with_ctx):
    qn_l, qr_l, kn_l, kr_l, v_l = mla_project(h_lat, w_down, q_norm_g, kv_norm_g, w_uq, w_ukv, rope)
    qn_c, qr_c, kn_c, kr_c, v_c = mla_project(h_ctx, w_down, q_norm_g, kv_norm_g, w_uq, w_ukv, None)
    kn_a = jnp.concatenate([kn_c, kn_l], axis=1)
    kr_a = jnp.concatenate([kr_c, kr_l], axis=1)
    v_a = jnp.concatenate([v_c, v_l], axis=1)
    o_lat = sweep_query_blocks(lambda qn, qr: mla_attend(qn, qr, kn_a, kr_a, v_a), qn_l, qr_l)
    b, s = o_lat.shape[:2]
    y_lat = o_lat.reshape(b, s, MLA_HEADS * MLA_V_DIM) @ w_o
    y_ctx = None
    if with_ctx:
        o_ctx = mla_attend(qn_c, qr_c, kn_c, kr_c, v_c)
        y_ctx = o_ctx.reshape(o_ctx.shape[0], o_ctx.shape[1], MLA_HEADS * MLA_V_DIM) @ w_o
    return y_lat, y_ctx


def setup_inputs(seed: int = 0) -> dict:
    key = jax.random.key(seed)
    ks = jax.random.split(key, 26)

    def nrm(k, shape, scale):
        return jax.random.normal(k, shape, jnp.float32) * scale

    def gain(k, shape):
        return 1.0 + 0.05 * jax.random.normal(k, shape, jnp.float32)

    d = D_MODEL
    return {
        "x": nrm(ks[0], (BATCH, SEQ, d), 1.0),
        "c": nrm(ks[1], (BATCH, d), 1.0),
        "ctx": nrm(ks[2], (BATCH, CTX_LEN, d), 1.0),
        "c_ctx": nrm(ks[3], (d,), 1.0),
        "mod_w": nrm(ks[4], (DEPTH, d, 6 * d), 0.5 * d ** -0.5),
        "mod_b": nrm(ks[5], (DEPTH, 6 * d), 0.02),
        "norm_mix_g": gain(ks[6], (DEPTH, d)),
        "norm_mlp_g": gain(ks[7], (DEPTH, d)),
        "final_g": gain(ks[8], (d,)),
        "mlp_w1": nrm(ks[9], (DEPTH, d, D_FF), d ** -0.5),
        "mlp_w2": nrm(ks[10], (DEPTH, D_FF, d), D_FF ** -0.5),
        "fourier_w": nrm(ks[11], (N_FOURIER, d, d), d ** -0.5),
        "fourier_b": nrm(ks[12], (N_FOURIER, d), 0.02),
        "diff_w_qkv": nrm(ks[13], (N_DIFF, d, 3 * d), d ** -0.5),
        "diff_lambda_q1": nrm(ks[14], (N_DIFF, DIFF_HEAD_DIM), 0.1),
        "diff_lambda_k1": nrm(ks[15], (N_DIFF, DIFF_HEAD_DIM), 0.1),
        "diff_lambda_q2": nrm(ks[16], (N_DIFF, DIFF_HEAD_DIM), 0.1),
        "diff_lambda_k2": nrm(ks[17], (N_DIFF, DIFF_HEAD_DIM), 0.1),
        "diff_subln_g": gain(ks[18], (N_DIFF, DIFF_V_DIM)),
        "diff_w_o": nrm(ks[19], (N_DIFF, d, d), d ** -0.5),
        "mla_w_down": nrm(ks[20], (N_MLA, d, MLA_DOWN), d ** -0.5),
        "mla_q_norm_g": gain(ks[21], (N_MLA, MLA_Q_RANK)),
        "mla_kv_norm_g": gain(ks[22], (N_MLA, MLA_KV_RANK)),
        "mla_w_uq": nrm(ks[23], (N_MLA, MLA_Q_RANK, MLA_HEADS * (MLA_NOPE_DIM + MLA_ROPE_DIM)), MLA_Q_RANK ** -0.5),
        "mla_w_ukv": nrm(ks[24], (N_MLA, MLA_KV_RANK, MLA_HEADS * (MLA_NOPE_DIM + MLA_V_DIM)), MLA_KV_RANK ** -0.5),
        "mla_w_o": nrm(ks[25], (N_MLA, MLA_HEADS * MLA_V_DIM, d), (MLA_HEADS * MLA_V_DIM) ** -0.5),
    }


def reference(x, c, ctx, c_ctx, mod_w, mod_b, norm_mix_g, norm_mlp_g, final_g, mlp_w1, mlp_w2,
              fourier_w, fourier_b, diff_w_qkv, diff_lambda_q1, diff_lambda_k1, diff_lambda_q2,
              diff_lambda_k2, diff_subln_g, diff_w_o, mla_w_down, mla_q_norm_g, mla_kv_norm_g,
              mla_w_uq, mla_w_ukv, mla_w_o):
    rows = x.shape[1] // GRID_W
    rope_diff = axial_rope_tables(rows, DIFF_HEAD_DIM)
    rope_mla = axial_rope_tables(rows, MLA_ROPE_DIM)
    silu_c = jax.nn.silu(c)[:, None, :]
    silu_cc = jax.nn.silu(c_ctx)
    x_lat, x_ctx = x, ctx
    for i in range(DEPTH):
        kind, j = i % N_MIXERS, i // N_MIXERS
        update_ctx = i < DEPTH - 1
        ctx_feeds_mixer = update_ctx or kind != 0
        sh_a, sc_a, g_a, sh_m, sc_m, g_m = jnp.split(silu_c @ mod_w[i] + mod_b[i], 6, axis=-1)
        h_lat = modulate(x_lat, norm_mix_g[i], sh_a, sc_a)
        if ctx_feeds_mixer:
            csh_a, csc_a, cg_a, csh_m, csc_m, cg_m = jnp.split(silu_cc @ mod_w[i] + mod_b[i], 6, axis=-1)
            h_ctx = modulate(x_ctx, norm_mix_g[i], csh_a, csc_a)
        if kind == 0:
            y_lat = fourier_mixer(h_lat, fourier_w[j], fourier_b[j])
            y_ctx = fourier_mixer(h_ctx, fourier_w[j], fourier_b[j]) if update_ctx else None
        elif kind == 1:
            y_lat, y_ctx = diff_attention_mixer(
                h_lat, h_ctx, diff_w_qkv[j], diff_lambda_q1[j], diff_lambda_k1[j], diff_lambda_q2[j],
                diff_lambda_k2[j], diff_subln_g[j], diff_w_o[j], i, rope_diff, update_ctx)
        else:
            y_lat, y_ctx = mla_mixer(
                h_lat, h_ctx, mla_w_down[j], mla_q_norm_g[j], mla_kv_norm_g[j], mla_w_uq[j],
                mla_w_ukv[j], mla_w_o[j], rope_mla, update_ctx)
        x_lat = x_lat + g_a * y_lat
        x_lat = x_lat + g_m * sq_relu_mlp(modulate(x_lat, norm_mlp_g[i], sh_m, sc_m), mlp_w1[i], mlp_w2[i])
        if update_ctx:
            x_ctx = x_ctx + cg_a * y_ctx
            x_ctx = x_ctx + cg_m * sq_relu_mlp(modulate(x_ctx, norm_mlp_g[i], csh_m, csc_m), mlp_w1[i], mlp_w2[i])
    return rms_norm(x_lat, final_g)
```

```cpp
#include <hip/hip_runtime.h>
#include <hip/hip_cooperative_groups.h>
#include <cstdio>
#include <cstdint>
namespace cg = cooperative_groups;
namespace pg8 {
#define PG8_LAS __attribute__((address_space(3)))
typedef unsigned short bf16_t;
typedef short bf16x8 __attribute__((ext_vector_type(8)));
typedef float f32x4 __attribute__((ext_vector_type(4)));
typedef unsigned u32x4 __attribute__((ext_vector_type(4)));
constexpr int BM = 256, BK = 64, HALF = 128, HTB = HALF * BK * 2  , STAGE_BYTES = 8 * HTB, NXCD = 8, WGM = 8;

__host__ __device__ __forceinline__ int lds_byte(int r, int c) { const int st = (r >> 4) * 2 + (c >> 5), rr = r & 15, cc = c & 31, ob = rr * 64 + cc * 2; return st * 1024 + (ob ^ (((ob >> 9) & 1) << 5)); }
__host__ __device__ __forceinline__ void stage_rc(int b, int& R, int& C) { const int st = b / 1024, sb = b % 1024, swz = sb ^ (((sb >> 9) & 1) << 5); R = (st >> 1) * 16 + swz / 64; C = (st & 1) * 32 + (swz % 64) / 2; }
__host__ __device__ __forceinline__ int perm32(int rho) { const int n = rho >> 4, i = rho & 15; return 8 * (i >> 2) + 4 * n + (i & 3); }

struct Unit { int pm, pn; };
struct Gemm { const bf16_t* A; const bf16_t* Bt; int M, N, K, lda, ldb; };

struct StaticOrder {
    int nM, nN, nwg, G, c;
    __host__ __device__ void init(int M, int N, int G_, int c_) { nM = M / BM; nN = N / BM; nwg = nM * nN; G = G_; c = c_; }
    __host__ __device__ bool next(int i, Unit& u) const {
        const long L = (long)i * G + c; if (L >= nwg) return false;
        int wgid = (int)L; { const int q = nwg / NXCD, r = nwg % NXCD, xcd = wgid % NXCD, off = wgid / NXCD; wgid = (xcd < r ? xcd * (q + 1) : r * (q + 1) + (xcd - r) * q) + off; }
        const int nig = WGM * nN, gid = wgid / nig, fm = gid * WGM, gsz = (nM - fm) < WGM ? (nM - fm) : WGM;
        u.pm = fm + ((wgid % nig) % gsz); u.pn = (wgid % nig) / gsz; return true;
    }
    __device__ __forceinline__ void a_ready(const Unit&) const {}
    __device__ __forceinline__ void done(const Unit&) const {}
    __device__ __forceinline__ size_t aoff(const Unit& u, size_t ts, int) const { return (size_t)u.pm * ts; }
    __device__ __forceinline__ size_t boff(const Unit& u, size_t ts, int) const { return (size_t)u.pn * ts; }
};
struct PartOrder : StaticOrder {
    __device__ __forceinline__ size_t aoff(const Unit& u, size_t ts, int K) const { return (size_t)(u.pm & 15) * ts + (size_t)(u.pm >> 4) * K * 2; }
    __device__ __forceinline__ size_t boff(const Unit& u, size_t ts, int K) const { return (size_t)u.pn * ts + (size_t)(u.pm >> 4) * K * 2; }
};


template <class Epi, class Sched, bool ALIGN_EPI = false, bool SP2 = false>
__device__ __forceinline__ void gemm_phase(PG8_LAS unsigned char* lds, const Gemm g, const Sched& S, const Epi& E) {
    int tid_l = threadIdx.x; asm volatile("" : "+v"(tid_l)); const int tid = tid_l, wid = __builtin_amdgcn_readfirstlane(tid >> 6), lane = tid & 63, wr = wid >> 2, wc = wid & 3, fr = lane & 15, fq = lane >> 4;
    int K_l = g.K; asm volatile("" : "+s"(K_l)); const int K = K_l, nt = K / BK;
    unsigned voffA[2], voffB[2];
#pragma unroll
    for (int i = 0; i < 2; ++i) { int R, C; stage_rc(tid * 16 + i * 8192, R, C); const int Rb = Epi::PERM ? ((R & ~31) + perm32(R & 31)) : R;
        voffA[i] = (unsigned)(R * g.lda + C) * 2u; voffB[i] = (unsigned)(Rb * g.ldb + C) * 2u; }
    const size_t kstep = (size_t)(BK * 2);
    const size_t hstepA = (size_t)HALF * g.lda * 2, hstepB = (size_t)HALF * g.ldb * 2;
    const size_t tstepA = 2 * hstepA, tstepB = 2 * hstepB;
    const unsigned ldsw = (unsigned)wid * 1024u;
    const int aoff = lds_byte(wr * 64 + fr, fq * 8), boff = lds_byte(wc * 32 + fr, fq * 8);
#define PG8_SA(b, h) (((b) * 2 + (h)) * HTB)
#define PG8_SB(b, h) ((4 + (b) * 2 + (h)) * HTB)
#define PG8_STAGE(bufoff, gbase, voff) do { _Pragma("unroll") for (int _i = 0; _i < 2; ++_i) \
        __builtin_amdgcn_global_load_lds((const unsigned*)((const char*)(gbase) + (voff)[_i]), (PG8_LAS unsigned*)(lds + (bufoff) + ldsw + _i * 8192), 16, 0, 0); } while (0)
#define PG8_LDA(dst, b, h) do { _Pragma("unroll") for (int m = 0; m < 4; ++m) _Pragma("unroll") for (int k = 0; k < 2; ++k) dst[m][k] = *(const PG8_LAS bf16x8*)(lds + PG8_SA(b, h) + aoff + m * 2048 + k * 1024); } while (0)
#define PG8_LDB(dst, b, h) do { _Pragma("unroll") for (int n = 0; n < 2; ++n) _Pragma("unroll") for (int k = 0; k < 2; ++k) dst[n][k] = *(const PG8_LAS bf16x8*)(lds + PG8_SB(b, h) + boff + n * 2048 + k * 1024); } while (0)
#define PG8_MMA(ai, bj, At, Bt) do { __builtin_amdgcn_s_setprio(1); _Pragma("unroll") for (int m = 0; m < 4; ++m) _Pragma("unroll") for (int n = 0; n < 2; ++n) _Pragma("unroll") for (int k = 0; k < 2; ++k) \
        acc[ai][bj][m][n] = __builtin_amdgcn_mfma_f32_16x16x32_bf16(Bt[n][k], At[m][k], acc[ai][bj][m][n], 0, 0, 0); __builtin_amdgcn_s_setprio(0); } while (0)
#define PG8_WAIT_V(n) asm volatile("s_waitcnt vmcnt(" #n ")" ::: "memory")
#define PG8_WAIT_L(n) asm volatile("s_waitcnt lgkmcnt(" #n ")" ::: "memory")
#define PG8_BAR __builtin_amdgcn_s_barrier()
#define PG8_SCHED __builtin_amdgcn_sched_barrier(0)
    Unit cur, nxt; int ui = 0;
    if (!S.next(0, cur)) return;
    f32x4 acc[2][2][4][2];
#pragma unroll
    for (int a = 0; a < 2; ++a)
#pragma unroll
        for (int b = 0; b < 2; ++b)
#pragma unroll
            for (int m = 0; m < 4; ++m)
#pragma unroll
                for (int n = 0; n < 2; ++n) acc[a][b][m][n] = (f32x4){0.f, 0.f, 0.f, 0.f};
    bf16x8 At[4][2], B0[2][2], B1[2][2];
    const char* cA = (const char*)g.A + S.aoff(cur, tstepA, K); const char* cB = (const char*)g.Bt + S.boff(cur, tstepB, K);
    S.a_ready(cur);
    if constexpr (SP2) {
        PG8_STAGE(PG8_SB(0, 0), cB, voffB); PG8_STAGE(PG8_SB(0, 1), cB + hstepB, voffB); PG8_STAGE(PG8_SA(0, 0), cA, voffA); PG8_STAGE(PG8_SA(0, 1), cA + hstepA, voffA);
        if (wr == 1) PG8_BAR;
        PG8_WAIT_V(2); PG8_BAR;
        PG8_STAGE(PG8_SB(1, 0), cB + kstep, voffB); PG8_STAGE(PG8_SA(1, 0), cA + kstep, voffA); PG8_STAGE(PG8_SB(1, 1), cB + hstepB + kstep, voffB);
        PG8_WAIT_V(6); PG8_BAR;
    } else {
        PG8_STAGE(PG8_SB(0, 0), cB, voffB); PG8_STAGE(PG8_SA(0, 0), cA, voffA); PG8_STAGE(PG8_SB(0, 1), cB + hstepB, voffB); PG8_STAGE(PG8_SA(0, 1), cA + hstepA, voffA);
        if (wr == 1) PG8_BAR;
        PG8_WAIT_V(4); PG8_BAR;
        PG8_STAGE(PG8_SB(1, 0), cB + kstep, voffB); PG8_STAGE(PG8_SA(1, 0), cA + kstep, voffA); PG8_STAGE(PG8_SB(1, 1), cB + hstepB + kstep, voffB);
        PG8_WAIT_V(6); PG8_BAR;
    }
    for (;;) {
        const bool has_next = S.next(ui + 1, nxt);
        const char* nA = has_next ? (const char*)g.A + S.aoff(nxt, tstepA, K) : cA; const char* nB = has_next ? (const char*)g.Bt + S.boff(nxt, tstepB, K) : cB;
        for (int t = 0; t < nt; t += 2) {
            const bool last = (t == nt - 2);
            const char* a1 = cA + (size_t)(t + 1) * kstep;
            const char* a2 = last ? nA : cA + (size_t)(t + 2) * kstep; const char* b2 = last ? nB : cB + (size_t)(t + 2) * kstep;
            const char* a3 = a2 + kstep; const char* b3 = b2 + kstep;
            if (last && has_next) S.a_ready(nxt);
            if constexpr (SP2) {
            PG8_LDB(B0, 0, 0); PG8_LDB(B1, 0, 1); PG8_SCHED; PG8_LDA(At, 0, 0); PG8_STAGE(PG8_SA(1, 1), a1 + hstepA, voffA);
            PG8_WAIT_V(8); PG8_WAIT_L(0); PG8_BAR; PG8_MMA(0, 0, At, B0); PG8_MMA(0, 1, At, B1); PG8_BAR; PG8_SCHED;
            PG8_LDA(At, 0, 1); PG8_STAGE(PG8_SB(0, 0), b2, voffB); PG8_STAGE(PG8_SB(0, 1), b2 + hstepB, voffB); PG8_STAGE(PG8_SA(0, 0), a2, voffA);
            PG8_WAIT_V(8); PG8_WAIT_L(0); PG8_BAR; PG8_MMA(1, 0, At, B0); PG8_MMA(1, 1, At, B1); PG8_BAR; PG8_SCHED;
            PG8_LDB(B0, 1, 0); PG8_LDB(B1, 1, 1); PG8_SCHED; PG8_LDA(At, 1, 0); PG8_STAGE(PG8_SA(0, 1), a2 + hstepA, voffA);
            PG8_WAIT_V(8); PG8_WAIT_L(0); PG8_BAR; PG8_MMA(0, 0, At, B0); PG8_MMA(0, 1, At, B1); PG8_BAR; PG8_SCHED;
            PG8_LDA(At, 1, 1); PG8_STAGE(PG8_SB(1, 0), b3, voffB); PG8_STAGE(PG8_SB(1, 1), b3 + hstepB, voffB); PG8_STAGE(PG8_SA(1, 0), a3, voffA);
            PG8_WAIT_V(8); PG8_WAIT_L(0); PG8_BAR; PG8_MMA(1, 0, At, B0); PG8_MMA(1, 1, At, B1); PG8_BAR; PG8_SCHED;
            } else {
            PG8_LDB(B0, 0, 0); PG8_SCHED; PG8_LDA(At, 0, 0); PG8_STAGE(PG8_SA(1, 1), a1 + hstepA, voffA);
            PG8_WAIT_L(8); PG8_BAR; PG8_WAIT_L(0); PG8_MMA(0, 0, At, B0); PG8_BAR; PG8_SCHED;
            PG8_LDB(B1, 0, 1); PG8_STAGE(PG8_SB(0, 0), b2, voffB);
            PG8_BAR; PG8_WAIT_L(0); PG8_MMA(0, 1, At, B1); PG8_BAR;
            PG8_LDA(At, 0, 1); PG8_STAGE(PG8_SA(0, 0), a2, voffA);
            PG8_BAR; PG8_WAIT_L(0); PG8_MMA(1, 0, At, B0); PG8_BAR; PG8_SCHED;
            PG8_STAGE(PG8_SB(0, 1), b2 + hstepB, voffB);
            PG8_WAIT_V(6); PG8_BAR; PG8_MMA(1, 1, At, B1); PG8_BAR;
            PG8_LDB(B0, 1, 0); PG8_SCHED; PG8_LDA(At, 1, 0); PG8_STAGE(PG8_SA(0, 1), a2 + hstepA, voffA);
            PG8_WAIT_L(8); PG8_BAR; PG8_WAIT_L(0); PG8_MMA(0, 0, At, B0); PG8_BAR; PG8_SCHED;
            PG8_LDB(B1, 1, 1); PG8_STAGE(PG8_SB(1, 0), b3, voffB);
            PG8_BAR; PG8_WAIT_L(0); PG8_MMA(0, 1, At, B1); PG8_BAR;
            PG8_LDA(At, 1, 1); PG8_STAGE(PG8_SA(1, 0), a3, voffA);
            PG8_BAR; PG8_WAIT_L(0); PG8_MMA(1, 0, At, B0); PG8_BAR; PG8_SCHED;
            PG8_STAGE(PG8_SB(1, 1), b3 + hstepB, voffB);
            PG8_WAIT_V(6); PG8_BAR; PG8_MMA(1, 1, At, B1); PG8_BAR;
            }
        }
        if constexpr (ALIGN_EPI) { if (wr == 0) PG8_BAR; }
        if constexpr (!Epi::AFTER_DRAIN) { Unit ce = cur; int fr_ = fr, fq_ = fq; asm volatile("" : "+s"(ce.pm), "+s"(ce.pn), "+v"(fr_), "+v"(fq_)); E(acc, ce, wr, wc, fr_, fq_); S.done(cur); }
        if (!has_next) break;
#pragma unroll
        for (int a = 0; a < 2; ++a)
#pragma unroll
            for (int b = 0; b < 2; ++b)
#pragma unroll
                for (int m = 0; m < 4; ++m)
#pragma unroll
                    for (int n = 0; n < 2; ++n) acc[a][b][m][n] = (f32x4){0.f, 0.f, 0.f, 0.f};
        cur = nxt; cA = nA; cB = nB; ++ui;
        if constexpr (ALIGN_EPI) { if (wr == 1) PG8_BAR; }
    }
    PG8_WAIT_V(0);
    if constexpr (!ALIGN_EPI) { if (wr == 0) PG8_BAR; }
    PG8_BAR;
    if constexpr (Epi::AFTER_DRAIN) { E.fused(acc, cur, wr, wc, fr, fq, lds, wid, lane); S.done(cur); }
#undef PG8_SA
#undef PG8_SB
#undef PG8_STAGE
#undef PG8_LDA
#undef PG8_LDB
#undef PG8_MMA
#undef PG8_WAIT_V
#undef PG8_WAIT_L
#undef PG8_BAR
#undef PG8_SCHED
}
}


namespace mk {
using pg8::bf16_t; using pg8::bf16x8; using pg8::f32x4; using pg8::u32x4;
#define LAS __attribute__((address_space(3)))
typedef short s16x4 __attribute__((ext_vector_type(4)));
typedef float f32x16 __attribute__((ext_vector_type(16)));
typedef unsigned u32x2 __attribute__((ext_vector_type(2)));
typedef float f32x2_t __attribute__((ext_vector_type(2)));
typedef __bf16 bf16x2_t __attribute__((ext_vector_type(2)));

constexpr int D = 1024, BATCH = 16, SEQ = 4096, CTX = 256, DFF = 4096, DEPTH = 4;
constexpr int NLAT = BATCH * SEQ, NCTX = BATCH * CTX, NTOK = NLAT + NCTX, KVLEN = CTX + SEQ, NB = BATCH + 1;
constexpr float EPS = 1e-6f;
constexpr float LOG2E = 1.4426950408889634f;
constexpr float LAM_INIT = 0.35550907f;
constexpr int MODROW = 6 * D;
constexpr int NWAVES = 8;
constexpr int LDS_BYTES = 143360;

constexpr size_t MiB = (size_t)1 << 20;
constexpr size_t WS_MOD = 0, WS_ROPE = 2 * MiB, WS_SSQ = 3 * MiB, WS_W1T = 4 * MiB, WS_W2T = 36 * MiB, WS_DQKV = 68 * MiB, WS_DWO = 74 * MiB,
                 WS_MDOWN = 76 * MiB, WS_MUQ = 77 * MiB, WS_MUKV = 78 * MiB, WS_MWO = 79 * MiB, WS_FWT = 81 * MiB, WS_FMW = 85 * MiB, WS_DFT256 = 93 * MiB,
                 WS_DFT4K = 94 * MiB, WS_XC = 158 * MiB, WS_H = 174 * MiB, WS_CQ = 310 * MiB, WS_KR = 378 * MiB, WS_BIG = 384 * MiB, WS_PART = 928 * MiB, WS_END = 992 * MiB;

__device__ __forceinline__ unsigned pk2(float lo, float hi) { f32x2_t v = {lo, hi}; bf16x2_t b = __builtin_convertvector(v, bf16x2_t); return __builtin_bit_cast(unsigned, b); }
__device__ __forceinline__ u32x2 pk4(f32x4 v) { u32x2 r; r.x = pk2(v[0], v[1]); r.y = pk2(v[2], v[3]); return r; }
__device__ __forceinline__ u32x4 pk8(f32x4 a, f32x4 b) { u32x4 r; r.x = pk2(a[0], a[1]); r.y = pk2(a[2], a[3]); r.z = pk2(b[0], b[1]); r.w = pk2(b[2], b[3]); return r; }
__device__ __forceinline__ unsigned short f2bf(float f) { unsigned u = __builtin_bit_cast(unsigned, f); return (unsigned short)((u + 0x7fffu + ((u >> 16) & 1u)) >> 16); }
__device__ __forceinline__ float wave_sum(float v) {
#pragma unroll
    for (int o = 1; o < 64; o <<= 1) v += __shfl_xor(v, o);
    return v;
}
__device__ __forceinline__ int kvrow_of(int r) { if (r < NLAT) return (r >> 12) * KVLEN + CTX + (r & 4095); const int rr = r - NLAT; return (rr >> 8) * KVLEN + (rr & 255); }
__device__ __forceinline__ f32x4 shfl_xor4(f32x4 v, int m) { f32x4 r; r[0] = __shfl_xor(v[0], m); r[1] = __shfl_xor(v[1], m); r[2] = __shfl_xor(v[2], m); r[3] = __shfl_xor(v[3], m); return r; }
__device__ __forceinline__ float dot4(f32x4 v) { return (v[0] * v[0] + v[1] * v[1]) + (v[2] * v[2] + v[3] * v[3]); }

typedef const f32x4 (&AccRef)[2][2][4][2];
__device__ __forceinline__ int fresh_tid() { int t = threadIdx.x; asm volatile("" : "+v"(t)); return t; }

struct EpiResid {
    static constexpr bool PERM = true, AFTER_DRAIN = false;
    const float* base_lat; const float* base_ctx; float* out_lat; float* out_ctx; const float* gate; const float* bias;
    __device__ __forceinline__ void operator()(AccRef acc, const pg8::Unit& u, int wr, int wc, int fr, int fq) const {
        const int row0 = u.pm * 256; const bool isctx = row0 >= NLAT;
        const int bidx = isctx ? BATCH : (row0 >> 12);
        const float* gp = gate + bidx * MODROW;
        const float* bp = isctx ? base_ctx : base_lat; float* op = isctx ? out_ctx : out_lat;
        const int rbase = (isctx ? row0 - NLAT : row0) + wr * 64 + fr;
        const int cbase = u.pn * 256 + wc * 32 + fq * 8;
#pragma unroll
        for (int bj = 0; bj < 2; ++bj) {
            const int col = cbase + bj * 128;
            const f32x4 g0 = *(const f32x4*)(gp + col), g1 = *(const f32x4*)(gp + col + 4);
            f32x4 b0 = {0.f, 0.f, 0.f, 0.f}, b1 = {0.f, 0.f, 0.f, 0.f}; if (bias) { b0 = *(const f32x4*)(bias + col); b1 = *(const f32x4*)(bias + col + 4); }
#pragma unroll
            for (int ai = 0; ai < 2; ++ai)
#pragma unroll
                for (int m = 0; m < 4; ++m) {
                    const size_t off = (size_t)(rbase + ai * 128 + m * 16) * D + col;
                    const f32x4 x0 = *(const f32x4*)(bp + off), x1 = *(const f32x4*)(bp + off + 4);
                    *(f32x4*)(op + off) = x0 + g0 * (acc[ai][bj][m][0] + b0);
                    *(f32x4*)(op + off + 4) = x1 + g1 * (acc[ai][bj][m][1] + b1);
                }
        }
    }
};
struct EpiResidPart {
    static constexpr bool PERM = true, AFTER_DRAIN = false;
    float* part0; const float* gate; const float* bias0;
    __device__ __forceinline__ void operator()(AccRef acc, const pg8::Unit& u, int wr, int wc, int fr, int fq) const {
        const float* gp = gate + BATCH * MODROW; const int pt = u.pm >> 4; float* part = part0 + (size_t)pt * NCTX * D; const float* bias = pt == 0 ? bias0 : nullptr;
        const int rbase = (u.pm & 15) * 256 + wr * 64 + fr, cbase = u.pn * 256 + wc * 32 + fq * 8;
#pragma unroll
        for (int bj = 0; bj < 2; ++bj) {
            const int col = cbase + bj * 128;
            const f32x4 g0 = *(const f32x4*)(gp + col), g1 = *(const f32x4*)(gp + col + 4);
            f32x4 b0 = {0.f, 0.f, 0.f, 0.f}, b1 = {0.f, 0.f, 0.f, 0.f}; if (bias) { b0 = *(const f32x4*)(bias + col); b1 = *(const f32x4*)(bias + col + 4); }
#pragma unroll
            for (int ai = 0; ai < 2; ++ai)
#pragma unroll
                for (int m = 0; m < 4; ++m) {
                    const size_t off = (size_t)(rbase + ai * 128 + m * 16) * D + col;
                    *(f32x4*)(part + off) = g0 * (acc[ai][bj][m][0] + b0); *(f32x4*)(part + off + 4) = g1 * (acc[ai][bj][m][1] + b1);
                }
        }
    }
};
struct EpiRelu2 {
    static constexpr bool PERM = true, AFTER_DRAIN = false;
    bf16_t* O; int ldc;
    __device__ __forceinline__ void operator()(AccRef acc, const pg8::Unit& u, int wr, int wc, int fr, int fq) const {
        bf16_t* base = O + (size_t)(u.pm * 256 + wr * 64 + fr) * ldc + u.pn * 256 + wc * 32 + 8 * fq;
#pragma unroll
        for (int ai = 0; ai < 2; ++ai)
#pragma unroll
            for (int m = 0; m < 4; ++m) { bf16_t* rowp = base + (size_t)(ai * 128 + m * 16) * ldc;
#pragma unroll
                for (int bj = 0; bj < 2; ++bj) { f32x4 v0 = acc[ai][bj][m][0], v1 = acc[ai][bj][m][1];
#pragma unroll
                    for (int j = 0; j < 4; ++j) { float a = fmaxf(v0[j], 0.f), b = fmaxf(v1[j], 0.f); v0[j] = a * a; v1[j] = b * b; }
                    *(u32x4*)(rowp + bj * 128) = pk8(v0, v1); } }
    }
};
struct EpiDft {
    static constexpr bool PERM = true, AFTER_DRAIN = false;
    bf16_t* G; int S, lgS, rowbase, mode; const float* hN;
    __device__ __forceinline__ void operator()(AccRef acc, const pg8::Unit& u, int wr, int wc, int fr, int fq) const {
        const int r0 = u.pm * 256, c0 = u.pn * 256, b = c0 >> 10, colo = (c0 & 1023) + wc * 32 + 8 * fq;
        if (mode == 0) {
            const int part = r0 >> lgS, k0 = r0 & (S - 1);
            bf16_t* base = G + (size_t)(rowbase + b * S + k0 + wr * 64 + fr) * 2048 + part * 1024 + colo;
#pragma unroll
            for (int ai = 0; ai < 2; ++ai)
#pragma unroll
                for (int m = 0; m < 4; ++m) { bf16_t* rowp = base + (size_t)(ai * 128 + m * 16) * 2048;
#pragma unroll
                    for (int bj = 0; bj < 2; ++bj) *(u32x4*)(rowp + bj * 128) = pk8(acc[ai][bj][m][0], acc[ai][bj][m][1]); }
        } else {
            bf16_t* Gb = G + (size_t)(rowbase + b * 4096) * 2048 + colo; const int ccol = c0 + wc * 32 + 8 * fq;
#pragma unroll
            for (int bj = 0; bj < 2; ++bj) {
                f32x4 h0 = {0.f, 0.f, 0.f, 0.f}, h1 = h0;
                if (mode == 1) { h0 = *(const f32x4*)(hN + ccol + bj * 128); h1 = *(const f32x4*)(hN + ccol + bj * 128 + 4); }
#pragma unroll
                for (int ai = 0; ai < 2; ++ai)
#pragma unroll
                    for (int m = 0; m < 4; ++m) {
                        const int k = r0 + ai * 128 + wr * 64 + m * 16 + fr;
                        if (mode == 1) {
                            const float sg = (k & 1) ? -1.f : 1.f; const u32x4 w = pk8(acc[ai][bj][m][0] + h0 * sg, acc[ai][bj][m][1] + h1 * sg);
                            *(u32x4*)(Gb + (size_t)k * 2048 + bj * 128) = w; if (k != 0) *(u32x4*)(Gb + (size_t)(4096 - k) * 2048 + bj * 128) = w;
                        } else {
                            const f32x4 v0 = acc[ai][bj][m][0], v1 = acc[ai][bj][m][1];
                            if (k == 0) { *(u32x4*)(Gb + 1024 + bj * 128) = (u32x4){0u, 0u, 0u, 0u}; *(u32x4*)(Gb + (size_t)2048 * 2048 + 1024 + bj * 128) = (u32x4){0u, 0u, 0u, 0u}; }
                            else { *(u32x4*)(Gb + (size_t)k * 2048 + 1024 + bj * 128) = pk8(v0, v1); *(u32x4*)(Gb + (size_t)(4096 - k) * 2048 + 1024 + bj * 128) = pk8(-v0, -v1); }
                        }
                    }
            }
        }
    }
};
struct EpiFw {
    static constexpr bool PERM = true, AFTER_DRAIN = false;
    bf16_t* FMW;
    __device__ __forceinline__ void operator()(AccRef acc, const pg8::Unit& u, int wr, int wc, int fr, int fq) const {
        const float sg = u.pn ? (-1.f / 1024.f) : (1.f / 1024.f);
        const int r0 = u.pm * 256, jg = r0 >> 10, j = jg >> 2, g = jg & 3, n0 = r0 & 1023;
        bf16_t* base = FMW + (size_t)j * 1024 * 2048 + (size_t)(n0 + wr * 64 + fr) * 2048 + (u.pn ? 1024 : 0) + g * 256 + wc * 32 + 8 * fq;
#pragma unroll
        for (int ai = 0; ai < 2; ++ai)
#pragma unroll
            for (int m = 0; m < 4; ++m) { bf16_t* rowp = base + (size_t)(ai * 128 + m * 16) * 2048;
#pragma unroll
                for (int bj = 0; bj < 2; ++bj) *(u32x4*)(rowp + bj * 128) = pk8(acc[ai][bj][m][0] * sg, acc[ai][bj][m][1] * sg); }
    }
};
struct EpiDiffQK {
    static constexpr bool PERM = true, AFTER_DRAIN = false;
    bf16_t* Q; bf16_t* Kb; const float* rc; const float* rs; float qscale;
    __device__ __forceinline__ void operator()(AccRef acc, const pg8::Unit& u, int wr, int wc, int fr, int fq) const {
        const int row0 = u.pm * 256; const bool isctx = row0 >= NLAT; const bool isK = u.pn >= 4;
        const int colbase = (u.pn & 3) * 256 + wc * 32 + fq * 8;
        const float sc = isK ? 1.f : qscale; const float sgn = (fq < 2) ? -1.f : 1.f;
#pragma unroll
        for (int ai = 0; ai < 2; ++ai)
#pragma unroll
            for (int m = 0; m < 4; ++m) {
                const int r = row0 + ai * 128 + wr * 64 + m * 16 + fr;
                const int s = r & 4095, p = (wc & 1) ? (s & 63) : (s >> 6);
                f32x4 cs0 = {1.f, 1.f, 1.f, 1.f}, cs1 = cs0, sn0 = {0.f, 0.f, 0.f, 0.f}, sn1 = sn0;
                if (!isctx) { const float* cp = rc + p * 16 + (fq & 1) * 8; const float* sp = rs + p * 16 + (fq & 1) * 8;
                    cs0 = *(const f32x4*)cp; cs1 = *(const f32x4*)(cp + 4); sn0 = *(const f32x4*)sp * sgn; sn1 = *(const f32x4*)(sp + 4) * sgn; }
                const int drow = isK ? kvrow_of(r) : r;
                bf16_t* dp = (isK ? Kb : Q) + (size_t)drow * D + colbase;
#pragma unroll
                for (int bj = 0; bj < 2; ++bj) {
                    const f32x4 v0 = acc[ai][bj][m][0], v1 = acc[ai][bj][m][1]; const f32x4 p0 = shfl_xor4(v0, 32), p1 = shfl_xor4(v1, 32);
                    *(u32x4*)(dp + bj * 128) = pk8((v0 * cs0 + p0 * sn0) * sc, (v1 * cs1 + p1 * sn1) * sc);
                }
            }
    }
};
struct EpiVt {
    static constexpr bool PERM = true, AFTER_DRAIN = false;
    bf16_t* VT; const float* ssq;
    __device__ __forceinline__ void operator()(AccRef acc, const pg8::Unit& u, int wr, int wc, int fr, int fq) const {
        const int n0 = u.pm * 256 + wr * 64 + fr, c0 = u.pn * 256; const bool isctx = c0 >= NLAT;
#pragma unroll
        for (int bj = 0; bj < 2; ++bj) {
            const int c = c0 + bj * 128 + wc * 32 + fq * 8;
            int b, kvpos; if (!isctx) { b = c >> 12; kvpos = CTX + (c & 4095); } else { const int cc = c - NLAT; b = cc >> 8; kvpos = cc & 255; }
            f32x4 s0 = {1.f, 1.f, 1.f, 1.f}, s1 = s0;
            if (ssq) { const f32x4 q0 = *(const f32x4*)(ssq + (size_t)c * 2), q1 = *(const f32x4*)(ssq + (size_t)c * 2 + 4), q2 = *(const f32x4*)(ssq + (size_t)c * 2 + 8), q3 = *(const f32x4*)(ssq + (size_t)c * 2 + 12);
                s0[0] = rsqrtf(q0[1] * (1.f / 128.f) + EPS); s0[1] = rsqrtf(q0[3] * (1.f / 128.f) + EPS); s0[2] = rsqrtf(q1[1] * (1.f / 128.f) + EPS); s0[3] = rsqrtf(q1[3] * (1.f / 128.f) + EPS);
                s1[0] = rsqrtf(q2[1] * (1.f / 128.f) + EPS); s1[1] = rsqrtf(q2[3] * (1.f / 128.f) + EPS); s1[2] = rsqrtf(q3[1] * (1.f / 128.f) + EPS); s1[3] = rsqrtf(q3[3] * (1.f / 128.f) + EPS); }
            bf16_t* dp = VT + (size_t)(b * 1024 + n0) * KVLEN + kvpos;
#pragma unroll
            for (int ai = 0; ai < 2; ++ai)
#pragma unroll
                for (int m = 0; m < 4; ++m) *(u32x4*)(dp + (size_t)(ai * 128 + m * 16) * KVLEN) = pk8(acc[ai][bj][m][0] * s0, acc[ai][bj][m][1] * s1);
        }
    }
};
struct EpiMlaDown {
    static constexpr bool PERM = true, AFTER_DRAIN = false;
    bf16_t* CQ; bf16_t* KR; float* ssq; const float* rc; const float* rs;
    __device__ __forceinline__ void operator()(AccRef acc, const pg8::Unit& u, int wr, int wc, int fr, int fq) const {
        const int row0 = u.pm * 256; const bool isctx = row0 >= NLAT; const float sgn = (fq & 1) ? 1.f : -1.f;
#pragma unroll
        for (int ai = 0; ai < 2; ++ai)
#pragma unroll
            for (int m = 0; m < 4; ++m) {
                const int r = row0 + ai * 128 + wr * 64 + m * 16 + fr;
                float sq = dot4(acc[ai][0][m][0]) + dot4(acc[ai][0][m][1]);
                if (u.pn == 0) sq += dot4(acc[ai][1][m][0]) + dot4(acc[ai][1][m][1]);
                sq += __shfl_xor(sq, 16); sq += __shfl_xor(sq, 32);
                if (fq == 0) atomicAdd(ssq + (size_t)r * 2 + (u.pn ? 1 : 0), sq);
                bf16_t* dp = CQ + (size_t)r * 512 + u.pn * 256 + wc * 32 + fq * 8;
                *(u32x4*)(dp) = pk8(acc[ai][0][m][0], acc[ai][0][m][1]);
                if (u.pn == 0) *(u32x4*)(dp + 128) = pk8(acc[ai][1][m][0], acc[ai][1][m][1]);
                else if (wc == 0) {
                    const int s = r & 4095; const int kvr = kvrow_of(r);
                    f32x4 v0 = acc[ai][1][m][0], v1 = acc[ai][1][m][1]; const f32x4 p0 = shfl_xor4(v0, 16), p1 = shfl_xor4(v1, 16);
                    if (!isctx) { const int p = (fq >> 1) ? (s & 63) : (s >> 6);
                        const f32x4 cs0 = *(const f32x4*)(rc + p * 8), cs1 = *(const f32x4*)(rc + p * 8 + 4), sn0 = *(const f32x4*)(rs + p * 8) * sgn, sn1 = *(const f32x4*)(rs + p * 8 + 4) * sgn;
                        v0 = v0 * cs0 + p0 * sn0; v1 = v1 * cs1 + p1 * sn1; }
                    *(u32x4*)(KR + (size_t)kvr * 32 + fq * 8) = pk8(v0, v1);
                }
            }
    }
};
struct EpiMlaQ {
    static constexpr bool PERM = true, AFTER_DRAIN = false;
    bf16_t* QM; const float* ssq; const float* rc; const float* rs; float qscale;
    __device__ __forceinline__ void operator()(AccRef acc, const pg8::Unit& u, int wr, int wc, int fr, int fq) const {
        const int row0 = u.pm * 256; const bool isctx = row0 >= NLAT; const float sgn = (fq & 1) ? 1.f : -1.f;
#pragma unroll
        for (int ai = 0; ai < 2; ++ai)
#pragma unroll
            for (int m = 0; m < 4; ++m) {
                const int r = row0 + ai * 128 + wr * 64 + m * 16 + fr; const int s = r & 4095;
                const float rstd = rsqrtf(ssq[(size_t)r * 2] * (1.f / 256.f) + EPS) * qscale;
                bf16_t* dp = QM + (size_t)r * 1536 + u.pn * 256 + wc * 32 + fq * 8;
#pragma unroll
                for (int bj = 0; bj < 2; ++bj) {
                    const int blk32 = u.pn * 8 + bj * 4 + wc; const bool isrope = (blk32 % 3) == 2;
                    f32x4 v0 = acc[ai][bj][m][0] * rstd, v1 = acc[ai][bj][m][1] * rstd;
                    if (isrope) { const f32x4 p0 = shfl_xor4(v0, 16), p1 = shfl_xor4(v1, 16);
                        if (!isctx) { const int p = (fq >> 1) ? (s & 63) : (s >> 6);
                            const f32x4 cs0 = *(const f32x4*)(rc + p * 8), cs1 = *(const f32x4*)(rc + p * 8 + 4), sn0 = *(const f32x4*)(rs + p * 8) * sgn, sn1 = *(const f32x4*)(rs + p * 8 + 4) * sgn;
                            v0 = v0 * cs0 + p0 * sn0; v1 = v1 * cs1 + p1 * sn1; } }
                    *(u32x4*)(dp + bj * 128) = pk8(v0, v1);
                }
            }
    }
};
struct EpiMlaK {
    static constexpr bool PERM = true, AFTER_DRAIN = false;
    bf16_t* Kb; const float* ssq;
    __device__ __forceinline__ void operator()(AccRef acc, const pg8::Unit& u, int wr, int wc, int fr, int fq) const {
        const int row0 = u.pm * 256;
#pragma unroll
        for (int ai = 0; ai < 2; ++ai)
#pragma unroll
            for (int m = 0; m < 4; ++m) {
                const int r = row0 + ai * 128 + wr * 64 + m * 16 + fr;
                const float rstd = rsqrtf(ssq[(size_t)r * 2 + 1] * (1.f / 128.f) + EPS);
                bf16_t* dp = Kb + (size_t)kvrow_of(r) * D + u.pn * 256 + wc * 32 + fq * 8;
#pragma unroll
                for (int bj = 0; bj < 2; ++bj) *(u32x4*)(dp + bj * 128) = pk8(acc[ai][bj][m][0] * rstd, acc[ai][bj][m][1] * rstd);
            }
    }
};

__device__ __forceinline__ void transpose_item(const float* W, int K, int N, bf16_t* WT, int mode, const float* kscale, LAS float* scr, int item, int lane) {
    const int nblk = N / 32, kb = item / nblk, nb = item % nblk, k0 = 64 * kb, n0 = 32 * nb;
#pragma unroll 8
    for (int i = 0; i < 32; ++i) { const int kk = 2 * i + (lane >> 5); float v = W[(size_t)(k0 + kk) * N + n0 + (lane & 31)]; if (kscale) v *= kscale[k0 + kk]; scr[kk * 33 + (lane & 31)] = v; }
    const int c = lane & 7;
#pragma unroll
    for (int j = 0; j < 4; ++j) { const int n = (lane >> 3) + 8 * j; const LAS float* s = scr + (8 * c) * 33 + n;
        u32x4 o; o.x = pk2(s[0 * 33], s[1 * 33]); o.y = pk2(s[2 * 33], s[3 * 33]); o.z = pk2(s[4 * 33], s[5 * 33]); o.w = pk2(s[6 * 33], s[7 * 33]);
        const int nn = n0 + n; const int drow = (mode == 1) ? ((nn >> 7) * 64 + (nn & 63) + ((nn & 64) ? 1024 : 0)) : nn;
        if (mode == 2) *(u32x4*)(WT + ((size_t)((k0 >> 8) * 1024 + nn)) * 256 + (k0 & 255) + 8 * c) = o;
        else *(u32x4*)(WT + (size_t)drow * K + k0 + 8 * c) = o; }
}

__device__ __forceinline__ void norm_row_compute(const float* xp, const float* g, const float* mp, int shoff, int scoff, int lane, u32x2 (&outv)[4], const float* pp = nullptr, float* wb = nullptr) {
    f32x4 v[4]; float ss = 0.f;
#pragma unroll
    for (int j = 0; j < 4; ++j) { v[j] = *(const f32x4*)(xp + j * 256 + lane * 4);
        if (pp) { const float* q = pp + j * 256 + lane * 4; v[j] = v[j] + ((*(const f32x4*)q + *(const f32x4*)(q + (size_t)NCTX * D)) + (*(const f32x4*)(q + (size_t)2 * NCTX * D) + *(const f32x4*)(q + (size_t)3 * NCTX * D))); *(f32x4*)(wb + j * 256 + lane * 4) = v[j]; }
        ss += dot4(v[j]); }
    ss = wave_sum(ss); const float rstd = rsqrtf(ss * (1.f / 1024.f) + EPS);
#pragma unroll
    for (int j = 0; j < 4; ++j) { const int col = j * 256 + lane * 4;
        const f32x4 gv = *(const f32x4*)(g + col), sc = *(const f32x4*)(mp + scoff + col), sh = *(const f32x4*)(mp + shoff + col);
        outv[j] = pk4(v[j] * rstd * gv * (sc + 1.f) + sh); }
}
__device__ __forceinline__ void norm_rows(const float* xl, const float* xc, int nrows, const float* g, const float* modl, int shoff, int scoff, bf16_t* H, const float* part, float* xcw) {
    const int tid = fresh_tid(), lane = tid & 63, gw = blockIdx.x * NWAVES + __builtin_amdgcn_readfirstlane(tid >> 6), ngw = gridDim.x * NWAVES;
    for (int row_ = gw; row_ < nrows; row_ += ngw) { const int row = nrows - 1 - row_;
        const bool isctx = row >= NLAT; const int bidx = isctx ? BATCH : (row >> 12);
        const float* xp = isctx ? xc + (size_t)(row - NLAT) * D : xl + (size_t)row * D;
        u32x2 o[4];
        if (isctx && part) norm_row_compute(xp, g, modl + bidx * MODROW, shoff, scoff, lane, o, part + (size_t)(row - NLAT) * D, xcw + (size_t)(row - NLAT) * D);
        else norm_row_compute(xp, g, modl + bidx * MODROW, shoff, scoff, lane, o);
#pragma unroll
        for (int j = 0; j < 4; ++j) *(u32x2*)(H + (size_t)row * D + j * 256 + lane * 4) = o[j];
    }
}
__device__ __forceinline__ void norm_rows_T(LAS unsigned char* lds, const float* xl, const float* xc, int nrows, const float* g, const float* modl, int shoff, int scoff, bf16_t* HT, float* hN, float* NYQ) {
    LAS bf16_t* tl = (LAS bf16_t*)lds;
    const int tid = fresh_tid(), lane = tid & 63, wid = __builtin_amdgcn_readfirstlane(tid >> 6);
    const int ntile = BATCH * 64 + (nrows > NLAT ? NCTX / 64 : 0);
    for (int tile_ = blockIdx.x; tile_ < ntile; tile_ += gridDim.x) { const int tile = ntile - 1 - tile_;
        const bool isctx = tile >= BATCH * 64;
        const int b = isctx ? ((tile - BATCH * 64) >> 2) : (tile >> 6);
        const int s0 = isctx ? ((tile - BATCH * 64) & 3) * 64 : (tile & 63) * 32;
        const int bidx = isctx ? BATCH : b;
        for (int i = 0; i < 8; ++i) { const int slot = wid * 8 + i;
            const float* xp;
            if (isctx) xp = xc + (size_t)(b * CTX + s0 + slot) * D;
            else { int tok = slot < 32 ? s0 + slot : SEQ - (s0 + slot - 32); if (s0 == 0 && slot == 32) tok = SEQ / 2; xp = xl + (size_t)(b * SEQ + tok) * D; }
            u32x2 o[4]; norm_row_compute(xp, g, modl + bidx * MODROW, shoff, scoff, lane, o);
#pragma unroll
            for (int j = 0; j < 4; ++j) *(LAS u32x2*)(tl + slot * 1028 + j * 256 + lane * 4) = o[j]; }
        __syncthreads();
        if (isctx) {
            bf16_t* dst = HT + (size_t)NLAT * D + (size_t)b * D * CTX;
            for (int k = 0; k < 16; ++k) { const int it = tid + 512 * k, d = it >> 3, c = it & 7;
                const LAS bf16_t* sp = tl + (8 * c) * 1028 + d;
                u32x4 w; w.x = (unsigned)sp[0] | ((unsigned)sp[1028] << 16); w.y = (unsigned)sp[2 * 1028] | ((unsigned)sp[3 * 1028] << 16);
                w.z = (unsigned)sp[4 * 1028] | ((unsigned)sp[5 * 1028] << 16); w.w = (unsigned)sp[6 * 1028] | ((unsigned)sp[7 * 1028] << 16);
                *(u32x4*)(dst + (size_t)d * CTX + s0 + 8 * c) = w; }
        } else {
            bf16_t* he_dst = HT + (size_t)b * D * 2048; bf16_t* ho_dst = HT + (size_t)BATCH * D * 2048 + (size_t)b * D * 2048;
            for (int k = 0; k < 8; ++k) { const int it = tid + 512 * k, d = it >> 2, c = it & 3;
                const LAS bf16_t* sp = tl + (8 * c) * 1028 + d;
                float he[8], ho[8]; float nq = 0.f;
#pragma unroll
                for (int j = 0; j < 8; ++j) { const float lo = __uint_as_float((unsigned)sp[j * 1028] << 16), hi = __uint_as_float((unsigned)sp[(32 + j) * 1028] << 16);
                    he[j] = lo + hi; ho[j] = lo - hi;
                    if (j == 0 && c == 0 && s0 == 0) { he[0] = lo; ho[0] = 0.f; hN[b * D + d] = hi; }
                    nq += (j & 1) ? -he[j] : he[j]; }
                u32x4 we, wo; we.x = pk2(he[0], he[1]); we.y = pk2(he[2], he[3]); we.z = pk2(he[4], he[5]); we.w = pk2(he[6], he[7]);
                wo.x = pk2(ho[0], ho[1]); wo.y = pk2(ho[2], ho[3]); wo.z = pk2(ho[4], ho[5]); wo.w = pk2(ho[6], ho[7]);
                *(u32x4*)(he_dst + (size_t)d * 2048 + s0 + 8 * c) = we; *(u32x4*)(ho_dst + (size_t)d * 2048 + s0 + 8 * c) = wo;
                nq += __shfl_xor(nq, 1); nq += __shfl_xor(nq, 2);
                if (c == 0) atomicAdd(NYQ + b * D + d, nq); }
        }
        __syncthreads();
    }
}

__device__ __forceinline__ int crow(int r, int hi) { return (r & 3) + 8 * (r >> 2) + 4 * hi; }
#define MFMA32(a, b, c) __builtin_amdgcn_mfma_f32_32x32x16_bf16((a), (b), (c), 0, 0, 0)
template <int BASE> __device__ __forceinline__ bf16x8 pack8(const f32x16& p) {
    u32x4 w; w.x = pk2(p[BASE], p[BASE + 1]); w.y = pk2(p[BASE + 2], p[BASE + 3]); w.z = pk2(p[BASE + 4], p[BASE + 5]); w.w = pk2(p[BASE + 6], p[BASE + 7]); return __builtin_bit_cast(bf16x8, w);
}
constexpr float ATT_THR = 8.f;
#define SGB(mask, n) __builtin_amdgcn_sched_group_barrier((mask), (n), 0)
#define SBAR0() __builtin_amdgcn_sched_barrier(0)
template <int NKD, int KSTRIDE> __device__ __forceinline__ void att_qk(const LAS unsigned char* kb, const bf16x8 (&qr)[NKD], f32x16& c0, f32x16& c1) {
    f32x16 z;
#pragma unroll
    for (int r = 0; r < 16; ++r) z[r] = 0.f;
#pragma unroll
    for (int d0 = 0; d0 < NKD; ++d0) { const bf16x8 k0 = *(const LAS bf16x8*)(kb + d0 * 32), k1 = *(const LAS bf16x8*)(kb + 32 * KSTRIDE + d0 * 32);
        c0 = MFMA32(k0, qr[d0], d0 == 0 ? z : c0); c1 = MFMA32(k1, qr[d0], d0 == 0 ? z : c1); }
}
template <int VSTRIDE> __device__ __forceinline__ void att_vpre(const LAS unsigned char* vb, bf16x8 (&vf)[8]) {
#pragma unroll
    for (int i = 0; i < 8; ++i) vf[i] = *(const volatile LAS bf16x8*)(vb + (i >> 2) * 32 * VSTRIDE + (i & 3) * 32);
}
template <int NKD, int KSTRIDE> __device__ __forceinline__ void att_kread(const LAS unsigned char* kb, bf16x8 (&kf)[2 * NKD]) {
#pragma unroll
    for (int d0 = 0; d0 < NKD; ++d0) { kf[2 * d0] = *(const volatile LAS bf16x8*)(kb + d0 * 32); kf[2 * d0 + 1] = *(const volatile LAS bf16x8*)(kb + 32 * KSTRIDE + d0 * 32); }
}
template <int NKD, int KSTRIDE, int VSTRIDE> __device__ __forceinline__ void att_regionA(const bf16x8 (&kf)[2 * NKD], const bf16x8 (&qr)[NKD], f32x16& c0, f32x16& c1,
                                                                            const f32x16& pp0, const f32x16& pp1, float& lrun, bf16x8 (&pf)[4], const LAS unsigned char* vb, bf16x8 (&vf)[8]) {
    SBAR0();
    __builtin_amdgcn_s_setprio(1);
    f32x16 z;
#pragma unroll
    for (int r = 0; r < 16; ++r) z[r] = 0.f;
#pragma unroll
    for (int d0 = 0; d0 < NKD; ++d0) { c0 = MFMA32(kf[2 * d0], qr[d0], d0 == 0 ? z : c0); c1 = MFMA32(kf[2 * d0 + 1], qr[d0], d0 == 0 ? z : c1); }
    float s0 = 0.f, s1 = 0.f;
#pragma unroll
    for (int r = 0; r < 16; ++r) { s0 += pp0[r]; s1 += pp1[r]; }
    pf[0] = pack8<0>(pp0); pf[1] = pack8<8>(pp0); pf[2] = pack8<0>(pp1); pf[3] = pack8<8>(pp1);
    lrun += s0 + s1;
    att_vpre<VSTRIDE>(vb, vf);
    asm volatile("" : "+v"(lrun), "+v"(pf[0]), "+v"(pf[1]), "+v"(pf[2]), "+v"(pf[3]));
    SGB(0x008, NKD / 2);
#pragma unroll
    for (int i = 0; i < 2 * NKD - NKD / 2; ++i) { SGB(0x008, 1); SGB(0x002, 48 / (2 * NKD - NKD / 2)); }
    SGB(0x100, 8);
    __builtin_amdgcn_s_setprio(0);
    SBAR0();
}
__device__ __forceinline__ bool att_decide(f32x16& c0, f32x16& c1, float& mhat, float& lrun, float& fsc) {
    c0 = c0 - mhat; c1 = c1 - mhat;
    float ra = fmaxf(fmaxf(c0[0], c0[1]), c0[2]), rb = fmaxf(fmaxf(c1[0], c1[1]), c1[2]);
#pragma unroll
    for (int r = 3; r < 15; r += 2) { ra = fmaxf(fmaxf(ra, c0[r]), c0[r + 1]); rb = fmaxf(fmaxf(rb, c1[r]), c1[r + 1]); }
    float rm = fmaxf(fmaxf(ra, rb), fmaxf(c0[15], c1[15]));
    { auto rr = __builtin_amdgcn_permlane32_swap(__float_as_uint(rm), __float_as_uint(rm), false, false); rm = fmaxf(__uint_as_float(rr[0]), __uint_as_float(rr[1])); }
    bool resc = false; fsc = 1.f;
    if (__builtin_expect(__any(rm > ATT_THR), 0)) { asm volatile("; rare: reference update" ::: "memory"); const float dl = fmaxf(rm, 0.f); mhat += dl; fsc = __builtin_amdgcn_exp2f(-dl); lrun *= fsc; c0 = c0 - dl; c1 = c1 - dl; resc = true; }
    return resc;
}
template <int NBLK, int VSTRIDE> __device__ __forceinline__ void att_regionB(const LAS unsigned char* vb, const bf16x8 (&pf)[4], f32x16 (&o)[NBLK], f32x16& c0, f32x16& c1, const bf16x8 (&vf)[8], bool doexp) {
    SBAR0();
    __builtin_amdgcn_s_setprio(1);
    bf16x8 vg[8];
    if (NBLK == 4) {
#pragma unroll
        for (int i = 0; i < 8; ++i) vg[i] = *(const LAS bf16x8*)(vb + (2 + (i >> 2)) * 32 * VSTRIDE + (i & 3) * 32);
    }
#pragma unroll
    for (int i = 0; i < 8; ++i) o[i >> 2] = MFMA32(pf[i & 3], vf[i], o[i >> 2]);
    if (NBLK == 4) {
#pragma unroll
        for (int i = 0; i < 8; ++i) o[(NBLK == 4 ? 2 : 0) + (i >> 2)] = MFMA32(pf[i & 3], vg[i], o[(NBLK == 4 ? 2 : 0) + (i >> 2)]);
    }
    if (doexp) {
#pragma unroll
        for (int r = 0; r < 16; ++r) { c0[r] = __builtin_amdgcn_exp2f(c0[r]); c1[r] = __builtin_amdgcn_exp2f(c1[r]); }
        asm volatile("" : "+v"(c0), "+v"(c1));
        if (NBLK == 4) {
#pragma unroll
            for (int i = 0; i < 8; ++i) { SGB(0x008, 1); SGB(0x400, 2); SGB(0x100, 1); }
#pragma unroll
            for (int i = 0; i < 8; ++i) { SGB(0x008, 1); SGB(0x400, 2); }
        } else {
#pragma unroll
            for (int i = 0; i < 8; ++i) { SGB(0x008, 1); SGB(0x400, 4); }
        }
    }
    __builtin_amdgcn_s_setprio(0);
    SBAR0();
}
template <int NBLK, int VSTRIDE> __device__ __forceinline__ float att_regionB1(const LAS unsigned char* vb, const bf16x8 (&pf)[4], f32x16 (&o)[NBLK], f32x16& c0, f32x16& c1, const bf16x8 (&vf)[8], bf16x8 (&vg)[8], float mhat) {
    SBAR0();
    constexpr int NH = 2 * NBLK;
    if (NBLK == 4) {
#pragma unroll
        for (int i = 0; i < 8; ++i) vg[i] = *(const LAS bf16x8*)(vb + (2 + (i >> 2)) * 32 * VSTRIDE + (i & 3) * 32);
    }
#pragma unroll
    for (int i = 0; i < NH; ++i) o[i >> 2] = MFMA32(pf[i & 3], vf[i], o[i >> 2]);
    c0 = c0 - mhat; c1 = c1 - mhat;
    float ra = fmaxf(fmaxf(c0[0], c0[1]), c0[2]), rb = fmaxf(fmaxf(c1[0], c1[1]), c1[2]);
#pragma unroll
    for (int r = 3; r < 15; r += 2) { ra = fmaxf(fmaxf(ra, c0[r]), c0[r + 1]); rb = fmaxf(fmaxf(rb, c1[r]), c1[r + 1]); }
    float rm = fmaxf(fmaxf(ra, rb), fmaxf(c0[15], c1[15]));
    { auto rr = __builtin_amdgcn_permlane32_swap(__float_as_uint(rm), __float_as_uint(rm), false, false); rm = fmaxf(__uint_as_float(rr[0]), __uint_as_float(rr[1])); }
    asm volatile("" : "+v"(rm), "+v"(c0), "+v"(c1));
#pragma unroll
    for (int i = 0; i < NH; ++i) { SGB(0x008, 1); SGB(0x002, 56 / NH); if (NBLK == 4) SGB(0x100, 1); }
    SBAR0();
    return rm;
}
template <int NBLK> __device__ __forceinline__ void att_regionB2(const bf16x8 (&pf)[4], f32x16 (&o)[NBLK], f32x16& c0, f32x16& c1, const bf16x8 (&vf)[8], const bf16x8 (&vg)[8]) {
    SBAR0();
    constexpr int NH = 2 * NBLK;
#pragma unroll
    for (int i = 0; i < NH; ++i) { if (NBLK == 4) o[2 + (i >> 2)] = MFMA32(pf[i & 3], vg[i], o[2 + (i >> 2)]); else o[1] = MFMA32(pf[i & 3], vf[4 + i], o[1]); }
#pragma unroll
    for (int r = 0; r < 16; ++r) { c0[r] = __builtin_amdgcn_exp2f(c0[r]); c1[r] = __builtin_amdgcn_exp2f(c1[r]); }
    asm volatile("" : "+v"(c0), "+v"(c1));
#pragma unroll
    for (int i = 0; i < NH; ++i) { SGB(0x008, 1); SGB(0x400, 32 / NH); }
    SBAR0();
}
__device__ __forceinline__ bool att_decide2(float rm, f32x16& c0, f32x16& c1, float& mhat, float& lrun, float& fsc) {
    bool resc = false; fsc = 1.f;
    if (__builtin_expect(__any(rm > ATT_THR), 0)) { asm volatile("; rare: reference update" ::: "memory"); const float dl = fmaxf(rm, 0.f); mhat += dl; fsc = __builtin_amdgcn_exp2f(-dl); lrun *= fsc; c0 = c0 - dl; c1 = c1 - dl; resc = true; }
    return resc;
}
template <int NBLK> __device__ __forceinline__ void att_rescale(f32x16 (&o)[NBLK], float fsc, int hi) {
#pragma unroll
    for (int r = 0; r < 16; ++r) { const float fr_ = __shfl(fsc, crow(r, hi));
#pragma unroll
        for (int k = 0; k < NBLK; ++k) o[k][r] *= fr_; }
}
__device__ __forceinline__ void att_first(f32x16& c0, f32x16& c1, float& mhat) {
    float rm = fmaxf(c0[0], c1[0]);
#pragma unroll
    for (int r = 1; r < 16; ++r) rm = fmaxf(rm, fmaxf(c0[r], c1[r]));
    rm = fmaxf(rm, __shfl_xor(rm, 32)); mhat = rm;
#pragma unroll
    for (int r = 0; r < 16; ++r) { c0[r] = __builtin_amdgcn_exp2f(c0[r] - mhat); c1[r] = __builtin_amdgcn_exp2f(c1[r] - mhat); }
}

__device__ __forceinline__ void glds16(const void* gsrc, unsigned lds_dst) { unsigned keep;
    asm volatile("s_mov_b32 %0, m0\n\ts_mov_b32 m0, %2\n\ts_nop 0\n\tglobal_load_lds_dwordx4 %1, off\n\ts_mov_b32 m0, %0" : "=&s"(keep) : "v"(gsrc), "s"(lds_dst) : "memory"); }
#define WAIT_BAR(N) asm volatile("s_waitcnt vmcnt(" #N ") lgkmcnt(0)\n\ts_barrier" ::: "memory")
__device__ __forceinline__ int pi_row(int i) { return (i & ~12) | ((i & 4) << 1) | ((i & 8) >> 1); }

constexpr int DK_STRIDE = 272, DV_STRIDE = 144, D_KB = 64 * DK_STRIDE, D_VB = 128 * DV_STRIDE, D_VRING = 3 * D_KB;
__device__ __forceinline__ void attn_diff_unit(LAS unsigned char* lds, const bf16_t* __restrict__ Q, const bf16_t* __restrict__ Kb, const bf16_t* __restrict__ VT, bf16_t* O,
                                               int qrow0, int b, int h, int ntiles, float lam, const float* subln_g) {
    int tid_l = threadIdx.x; asm volatile("" : "+v"(tid_l)); const int tid = tid_l, lane = tid & 63, r32 = lane & 31, hi = lane >> 5;
    const int wid = __builtin_amdgcn_readfirstlane(tid >> 6), sub = wid >> 2, wq = wid & 3;
    const unsigned lds0 = (unsigned)(size_t)lds;
    bf16x8 qr[4];
    { const bf16_t* qp = Q + (size_t)(qrow0 + 32 * wq + r32) * D + h * 128 + sub * 64 + hi * 8;
#pragma unroll
      for (int d0 = 0; d0 < 4; ++d0) qr[d0] = *(const bf16x8*)(qp + d0 * 16); }
    asm volatile("s_waitcnt vmcnt(0)" ::: "memory");
    const bf16_t* kbase = Kb + (size_t)b * KVLEN * D + h * 128; const bf16_t* vbase = VT + (size_t)(b * 1024 + h * 128) * KVLEN;
    int poff[5], pdst[5]; const bool w0 = (wid == 0);
#pragma unroll
    for (int j = 0; j < 5; ++j) { int P = wid + 8 * j; if (P >= 35) P -= 8;
        const bool isk = (j < 2) || (j == 2 && w0);
        const int pk = isk ? P : P - 17, g = pk * 64 + lane;
        const int ik = g / 17, cik = g - ik * 17, iv = g / 9, civ = g - iv * 9;
        poff[j] = isk ? pi_row(ik) * D + (cik > 15 ? 15 : cik) * 8 : iv * KVLEN + (civ > 7 ? 7 : civ) * 8; pdst[j] = pk * 1024; }
    int ks3 = 0, vs4 = 0;
    int tiss = 0;
#define D_ISSUE() do { const bf16_t* kb_ = kbase + (size_t)tiss * 65536; const bf16_t* vb_ = vbase + (size_t)tiss * 64; \
        const unsigned kd_ = lds0 + ks3 * D_KB, vd_ = lds0 + D_VRING + vs4 * D_VB; \
        glds16(kb_ + poff[0], (unsigned)__builtin_amdgcn_readfirstlane(kd_ + pdst[0])); glds16(kb_ + poff[1], (unsigned)__builtin_amdgcn_readfirstlane(kd_ + pdst[1])); \
        glds16((w0 ? kb_ : vb_) + poff[2], (unsigned)__builtin_amdgcn_readfirstlane((w0 ? kd_ : vd_) + pdst[2])); \
        glds16(vb_ + poff[3], (unsigned)__builtin_amdgcn_readfirstlane(vd_ + pdst[3])); glds16(vb_ + poff[4], (unsigned)__builtin_amdgcn_readfirstlane(vd_ + pdst[4])); \
        ++tiss; ks3 = (ks3 == 2) ? 0 : ks3 + 1; vs4 = (vs4 + 1) & 3; } while (0)
    const int koff = r32 * DK_STRIDE + (sub * 64 + hi * 8) * 2;
    const int voff = D_VRING + r32 * DV_STRIDE + hi * 16;
    D_ISSUE(); D_ISSUE();
    f32x16 o[4];
#pragma unroll
    for (int k = 0; k < 4; ++k)
#pragma unroll
        for (int r = 0; r < 16; ++r) o[k][r] = 0.f;
    float mhat = 0.f, lrun = 0.f, fsc = 1.f;
    f32x16 pA0, pA1, pB0, pB1; bf16x8 pf[4], vf[8];
    WAIT_BAR(5);
    D_ISSUE();
    att_qk<4, DK_STRIDE>(lds + koff, qr, pA0, pA1);
    att_first(pA0, pA1, mhat);
    WAIT_BAR(5);
    int kc = 1, vc = 0;
#define D_STEP(C0, C1, P0, P1) do { \
        bf16x8 kf_[8]; att_kread<4, DK_STRIDE>(lds + kc * D_KB + koff, kf_); \
        if (sub == 0) D_ISSUE(); \
        att_regionA<4, DK_STRIDE, DV_STRIDE>(kf_, qr, C0, C1, P0, P1, lrun, pf, lds + vc * D_VB + voff, vf); \
        if (sub != 0) D_ISSUE(); \
        bf16x8 vg_[8]; const float rm_ = att_regionB1<4, DV_STRIDE>(lds + vc * D_VB + voff, pf, o, C0, C1, vf, vg_, mhat); \
        const bool resc_ = att_decide2(rm_, C0, C1, mhat, lrun, fsc); \
        att_regionB2<4>(pf, o, C0, C1, vf, vg_); \
        if (__builtin_expect(resc_, 0)) { asm volatile("; rare: rescale O" ::: "memory"); att_rescale<4>(o, fsc, hi); } \
        kc = (kc == 2) ? 0 : kc + 1; vc = (vc + 1) & 3; \
        WAIT_BAR(5); } while (0)
    int t = 1;
    for (; t + 1 < ntiles; t += 2) { D_STEP(pB0, pB1, pA0, pA1); D_STEP(pA0, pA1, pB0, pB1); }
    D_STEP(pB0, pB1, pA0, pA1);
    { float s = 0.f;
#pragma unroll
      for (int r = 0; r < 16; ++r) s += pB0[r] + pB1[r];
      lrun += s; pf[0] = pack8<0>(pB0); pf[1] = pack8<8>(pB0); pf[2] = pack8<0>(pB1); pf[3] = pack8<8>(pB1);
      att_vpre<DV_STRIDE>(lds + vc * D_VB + voff, vf); att_regionB<4, DV_STRIDE>(lds + vc * D_VB + voff, pf, o, pA0, pA1, vf, false); }
    WAIT_BAR(0);
#undef D_ISSUE
#undef D_STEP
    asm volatile("" : "+s"(qrow0), "+s"(h));
    { const float ltot = lrun + __shfl_xor(lrun, 32); const float inv = 1.f / ltot;
#pragma unroll
      for (int r = 0; r < 16; ++r) { const float ri = __shfl(inv, crow(r, hi));
#pragma unroll
          for (int k = 0; k < 4; ++k) o[k][r] *= ri; } }
    LAS float* ex = (LAS float*)lds;
    if (sub == 1) {
#pragma unroll
        for (int k = 0; k < 4; ++k)
#pragma unroll
            for (int r = 0; r < 16; ++r) ex[(wq * 64 + k * 16 + r) * 64 + lane] = o[k][r];
    }
    __syncthreads();
    if (sub == 0) {
        float ssq[16];
#pragma unroll
        for (int r = 0; r < 16; ++r) { float s = 0.f;
#pragma unroll
            for (int k = 0; k < 4; ++k) { const float d = o[k][r] - lam * ex[(wq * 64 + k * 16 + r) * 64 + lane]; o[k][r] = d; s += d * d; }
            s += __shfl_xor(s, 1); s += __shfl_xor(s, 2); s += __shfl_xor(s, 4); s += __shfl_xor(s, 8); s += __shfl_xor(s, 16);
            ssq[r] = rsqrtf(s * (1.f / 128.f) + EPS); }
#pragma unroll
        for (int k = 0; k < 4; ++k) { const float g = subln_g[k * 32 + r32] * (1.f - LAM_INIT);
#pragma unroll
            for (int r = 0; r < 16; ++r) O[(size_t)(qrow0 + 32 * wq + crow(r, hi)) * D + h * 128 + k * 32 + r32] = f2bf(o[k][r] * ssq[r] * g); }
    }
    asm volatile("s_waitcnt vmcnt(0)" ::: "memory");
    __syncthreads();
}

constexpr int MK_STRIDE = 208, MV_STRIDE = 144, M_KB = 64 * MK_STRIDE, M_VB = 64 * MV_STRIDE, M_VRING = 3 * M_KB;
__device__ __forceinline__ void attn_mla_unit(LAS unsigned char* lds, const bf16_t* __restrict__ QM, const bf16_t* __restrict__ Kb, const bf16_t* __restrict__ KR, const bf16_t* __restrict__ VT, bf16_t* O,
                                              int qrow0, int b, int h, int ntiles) {
    int tid_l = threadIdx.x; asm volatile("" : "+v"(tid_l)); const int tid = tid_l, lane = tid & 63, r32 = lane & 31, hi = lane >> 5;
    const int wid = __builtin_amdgcn_readfirstlane(tid >> 6);
    const unsigned lds0 = (unsigned)(size_t)lds;
    bf16x8 qr[6];
    { const bf16_t* qp = QM + (size_t)(qrow0 + 32 * wid + r32) * 1536 + h * 96 + hi * 8;
#pragma unroll
      for (int d0 = 0; d0 < 6; ++d0) qr[d0] = *(const bf16x8*)(qp + d0 * 16); }
    asm volatile("s_waitcnt vmcnt(0)" ::: "memory");
    const bf16_t* kbase = Kb + (size_t)b * KVLEN * D + h * 64; const bf16_t* rbase = KR + (size_t)b * KVLEN * 32; const bf16_t* vbase = VT + (size_t)(b * 1024 + h * 64) * KVLEN;
    int poff[3], pdst[3], pstep[3]; bool pisk[3], pisr[3];
#pragma unroll
    for (int j = 0; j < 3; ++j) { int P = wid + 8 * j; if (P >= 22) P -= 8;
        if (P < 13) { const int g = P * 64 + lane, i = g / 13; int cin = g - i * 13; cin = cin > 11 ? 11 : cin; const int key = pi_row(i);
            pisr[j] = cin >= 8; poff[j] = pisr[j] ? key * 32 + (cin - 8) * 8 : key * D + cin * 8; pstep[j] = pisr[j] ? 2048 : 65536; pdst[j] = P * 1024; pisk[j] = true; }
        else { const int p = P - 13, g = p * 64 + lane, dv = g / 9; int cin = g - dv * 9; cin = cin > 7 ? 7 : cin; poff[j] = dv * KVLEN + cin * 8; pstep[j] = 64; pdst[j] = p * 1024; pisk[j] = false; pisr[j] = false; } }
    int ks3 = 0, vs4 = 0, tiss = 0;
#define M_ISSUE() do { const unsigned kd_ = lds0 + ks3 * M_KB, vd_ = lds0 + M_VRING + vs4 * M_VB; \
        _Pragma("unroll") for (int j = 0; j < 3; ++j) { \
            if (pisk[j]) { const bf16_t* src_ = (pisr[j] ? rbase : kbase) + (size_t)(poff[j] + tiss * pstep[j]); glds16(src_, (unsigned)__builtin_amdgcn_readfirstlane(kd_ + pdst[j])); } \
            else glds16(vbase + (size_t)(poff[j] + tiss * 64), (unsigned)__builtin_amdgcn_readfirstlane(vd_ + pdst[j])); } \
        ++tiss; ks3 = (ks3 == 2) ? 0 : ks3 + 1; vs4 = (vs4 + 1) & 3; } while (0)
    const int koff = r32 * MK_STRIDE + hi * 16;
    const int voff = M_VRING + r32 * MV_STRIDE + hi * 16;
    M_ISSUE(); M_ISSUE();
    f32x16 o[2];
#pragma unroll
    for (int k = 0; k < 2; ++k)
#pragma unroll
        for (int r = 0; r < 16; ++r) o[k][r] = 0.f;
    float mhat = 0.f, lrun = 0.f, fsc = 1.f;
    f32x16 pA0, pA1, pB0, pB1; bf16x8 pf[4], vf[8];
    WAIT_BAR(3);
    M_ISSUE();
    att_qk<6, MK_STRIDE>(lds + koff, qr, pA0, pA1);
    att_first(pA0, pA1, mhat);
    WAIT_BAR(3);
    int kc = 1, vc = 0;
#define M_STEP(C0, C1, P0, P1) do { \
        bf16x8 kf_[12]; att_kread<6, MK_STRIDE>(lds + kc * M_KB + koff, kf_); \
        if (wid < 4) M_ISSUE(); \
        att_regionA<6, MK_STRIDE, MV_STRIDE>(kf_, qr, C0, C1, P0, P1, lrun, pf, lds + vc * M_VB + voff, vf); \
        if (wid >= 4) M_ISSUE(); \
        bf16x8 vg_[8]; const float rm_ = att_regionB1<2, MV_STRIDE>(lds + vc * M_VB + voff, pf, o, C0, C1, vf, vg_, mhat); \
        const bool resc_ = att_decide2(rm_, C0, C1, mhat, lrun, fsc); \
        att_regionB2<2>(pf, o, C0, C1, vf, vg_); \
        if (__builtin_expect(resc_, 0)) { asm volatile("; rare: rescale O" ::: "memory"); att_rescale<2>(o, fsc, hi); } \
        kc = (kc == 2) ? 0 : kc + 1; vc = (vc + 1) & 3; \
        WAIT_BAR(3); } while (0)
    int t = 1;
    for (; t + 1 < ntiles; t += 2) { M_STEP(pB0, pB1, pA0, pA1); M_STEP(pA0, pA1, pB0, pB1); }
    M_STEP(pB0, pB1, pA0, pA1);
    { float s = 0.f;
#pragma unroll
      for (int r = 0; r < 16; ++r) s += pB0[r] + pB1[r];
      lrun += s; pf[0] = pack8<0>(pB0); pf[1] = pack8<8>(pB0); pf[2] = pack8<0>(pB1); pf[3] = pack8<8>(pB1);
      att_vpre<MV_STRIDE>(lds + vc * M_VB + voff, vf); att_regionB<2, MV_STRIDE>(lds + vc * M_VB + voff, pf, o, pA0, pA1, vf, false); }
    WAIT_BAR(0);
#undef M_ISSUE
#undef M_STEP
    asm volatile("" : "+s"(qrow0), "+s"(h));
    const float ltot = lrun + __shfl_xor(lrun, 32); const float inv = 1.f / ltot;
#pragma unroll
    for (int r = 0; r < 16; ++r) { const float ri = __shfl(inv, crow(r, hi));
#pragma unroll
        for (int k = 0; k < 2; ++k) O[(size_t)(qrow0 + 32 * wid + crow(r, hi)) * D + h * 64 + k * 32 + r32] = f2bf(o[k][r] * ri); }
    asm volatile("s_waitcnt vmcnt(0)" ::: "memory");
}

#define XB_TMO      128
#define XB_XCNT(j)  (256  + 64 * (j))
#define XB_XSUB(j)  (1280 + 64 * (j))
#define XB_XGEN(j)  (2304 + 64 * (j))
#define XB_TOP      3328
#define XB_TOPGEN   3392
#define XCD_BAR_WORDS 3456
#define XB_SPIN_CAP (1u << 18)

__device__ __forceinline__ unsigned xb_ld(unsigned* p)              { return __hip_atomic_load(p, __ATOMIC_RELAXED, __HIP_MEMORY_SCOPE_AGENT); }
__device__ __forceinline__ unsigned xb_add(unsigned* p, unsigned v) { return __hip_atomic_fetch_add(p, v, __ATOMIC_RELAXED, __HIP_MEMORY_SCOPE_AGENT); }
__device__ __forceinline__ unsigned xb_xcc_id() { return (unsigned)__builtin_amdgcn_s_getreg((3 << 11) | 20) & 0xFu; }
#define XB_SPIN(cond, bar) do { unsigned _sp = 0; while (cond) { __builtin_amdgcn_s_sleep(1); \
    if ((++_sp & 255u) == 0u) { if (xb_ld(&(bar)[XB_TMO])) break; if (_sp > XB_SPIN_CAP) { atomicAdd(&(bar)[XB_TMO], 1u); break; } } } } while (0)

struct XcdBarrier {
    unsigned* bar; unsigned x;
    volatile LAS unsigned* st;
};

__device__ __forceinline__ XcdBarrier xcd_barrier_post(unsigned* bar, volatile LAS unsigned* st) {
    XcdBarrier b; b.bar = bar; b.x = xb_xcc_id(); b.st = st;
    if (threadIdx.x == 0) (void)xb_add(&bar[XB_XCNT(b.x)], 1u);
    return b;
}
__device__ __forceinline__ void xcd_barrier_complete(unsigned* bar, unsigned x, unsigned& nloc, unsigned& nx) {
    const unsigned G = gridDim.x * gridDim.y * gridDim.z;
    unsigned sum, cnt, mine, sp = 0u;
    for (;;) {
        sum = 0u; cnt = 0u; mine = 0u;
#pragma unroll
        for (unsigned j = 0; j < 16; ++j) { const unsigned c = xb_ld(&bar[XB_XCNT(j)]); sum += c; cnt += (c > 0u) ? 1u : 0u; mine = (j == x) ? c : mine; }
        if (sum == G) break;
        __builtin_amdgcn_s_sleep(1);
        if ((++sp & 255u) == 0u) { if (xb_ld(&bar[XB_TMO])) break; if (sp > XB_SPIN_CAP) { atomicAdd(&bar[XB_TMO], 1u); break; } }
    }
    nloc = mine > 0u ? mine : 1u; nx = cnt > 0u ? cnt : 1u;
}

__device__ __forceinline__ void xcd_barrier(const XcdBarrier& b) {
    asm volatile("s_waitcnt vmcnt(0)" ::: "memory");
    __syncthreads();
    if (threadIdx.x == 0) {
        unsigned* bar = b.bar;
        __builtin_amdgcn_s_waitcnt(0);
        unsigned nloc = b.st[0], nx = b.st[1];
        if (nloc == 0u) { xcd_barrier_complete(bar, b.x, nloc, nx); b.st[0] = nloc; b.st[1] = nx; }
        const unsigned old = xb_add(&bar[XB_XSUB(b.x)], 1u);
        const unsigned gen = old / nloc;
        if (old + 1u == (gen + 1u) * nloc) {
            __builtin_amdgcn_fence(__ATOMIC_RELEASE, "agent");
            asm volatile("s_waitcnt vmcnt(0)" ::: "memory");
            const unsigned og = xb_add(&bar[XB_TOP], 1u);
            const unsigned tg = og / nx;
            if (og + 1u == (tg + 1u) * nx) xb_add(&bar[XB_TOPGEN], 1u);
            else XB_SPIN(xb_ld(&bar[XB_TOPGEN]) == tg, bar);
            __builtin_amdgcn_fence(__ATOMIC_ACQUIRE, "agent");
            xb_add(&bar[XB_XGEN(b.x)], 1u);
            asm volatile("s_waitcnt vmcnt(0)" ::: "memory");
        } else {
            XB_SPIN(xb_ld(&bar[XB_XGEN(b.x)]) == gen, bar);
            __builtin_amdgcn_fence(__ATOMIC_ACQUIRE, "agent");
            asm volatile("s_waitcnt vmcnt(0)" ::: "memory");
        }
    }
    __syncthreads();
}

struct Args { const float* in[26]; float* out; unsigned char* ws; };

#define GEMM_CALL(EPI, gA, gB, gM, gN, gK, gLDA, gLDB, cshift, Eobj) do { \
        pg8::Gemm gg__{(gA), (gB), (gM), (gN), (gK), (gLDA), (gLDB)}; pg8::StaticOrder so__; so__.init((gM), (gN), G, (int)((blockIdx.x + G - ((cshift) % G)) % G)); \
        pg8::gemm_phase<EPI, pg8::StaticOrder, true, true>(lds, gg__, so__, (Eobj)); } while (0)

__global__ void __launch_bounds__(512, 2) fwd_megakernel(Args a) {
    extern __shared__ __attribute__((aligned(16))) unsigned char lds_raw[];
    LAS unsigned char* lds = (LAS unsigned char*)lds_raw;
    const int G = gridDim.x;
    unsigned char* ws = a.ws;
    const float* x_in = a.in[0]; const float* c_in = a.in[1]; const float* ctx_in = a.in[2]; const float* cctx_in = a.in[3];
    const float* mod_w = a.in[4]; const float* mod_b = a.in[5]; const float* norm_mix_g = a.in[6]; const float* norm_mlp_g = a.in[7]; const float* final_g = a.in[8];
    float* out = a.out;
    float* MOD = (float*)(ws + WS_MOD);
    float* ropeDc = (float*)(ws + WS_ROPE); float* ropeDs = ropeDc + 1024; float* ropeMc = ropeDc + 2048; float* ropeMs = ropeDc + 2560; float* lamp = ropeDc + 3072;
    float* SSQ = (float*)(ws + WS_SSQ);
    unsigned* BARW = (unsigned*)(ws + WS_ROPE + 65536); float* NYQ = (float*)(ws + WS_ROPE + 131072); float* HN = (float*)(ws + WS_ROPE + 196608);
    bf16_t* W1T = (bf16_t*)(ws + WS_W1T); bf16_t* W2T = (bf16_t*)(ws + WS_W2T); bf16_t* DQKV = (bf16_t*)(ws + WS_DQKV); bf16_t* DWO = (bf16_t*)(ws + WS_DWO);
    bf16_t* MDOWN = (bf16_t*)(ws + WS_MDOWN); bf16_t* MUQ = (bf16_t*)(ws + WS_MUQ); bf16_t* MUKV = (bf16_t*)(ws + WS_MUKV); bf16_t* MWO = (bf16_t*)(ws + WS_MWO);
    bf16_t* FWT = (bf16_t*)(ws + WS_FWT); bf16_t* FMW = (bf16_t*)(ws + WS_FMW); bf16_t* DFT256 = (bf16_t*)(ws + WS_DFT256); bf16_t* DFT4K = (bf16_t*)(ws + WS_DFT4K);
    float* XC = (float*)(ws + WS_XC); bf16_t* H = (bf16_t*)(ws + WS_H); bf16_t* CQ = (bf16_t*)(ws + WS_CQ); bf16_t* KR = (bf16_t*)(ws + WS_KR);
    bf16_t* BIG = (bf16_t*)(ws + WS_BIG); float* PART = (float*)(ws + WS_PART);

    {
        const int tid = fresh_tid(), lane = tid & 63, wid = __builtin_amdgcn_readfirstlane(tid >> 6);
        const int gw = blockIdx.x * NWAVES + wid, ngw = G * NWAVES;
        const size_t gtid = (size_t)blockIdx.x * 512 + tid, gthreads = (size_t)G * 512;
        if (blockIdx.x == 0) for (int i = tid; i < XCD_BAR_WORDS; i += 512) BARW[i] = 0u;
        if (tid < 4) ((volatile LAS unsigned*)(lds + LDS_BYTES - 16))[tid] = 0u;
        LAS float* s_silu = (LAS float*)lds;
        LAS float* red = (LAS float*)(lds + NB * 1024 * 4);
        if ((int)blockIdx.x < DEPTH * 96) {
            for (int i = tid; i < NB * 1024; i += 512) { const float v = (i < BATCH * 1024) ? c_in[i] : cctx_in[i - BATCH * 1024]; s_silu[i] = v / (1.f + __expf(-v)); }
            __syncthreads();
            for (int item = blockIdx.x; item < DEPTH * 96; item += G) {
                const int l = item / 96, chunk = item % 96, n = chunk * 64 + lane;
                float acc[NB];
#pragma unroll
                for (int j = 0; j < NB; ++j) acc[j] = 0.f;
                const float* wp = mod_w + ((size_t)l * 1024 + 128 * wid) * MODROW + n;
                for (int k4 = 0; k4 < 32; ++k4) {
                    const float w0 = wp[(size_t)(4 * k4 + 0) * MODROW], w1 = wp[(size_t)(4 * k4 + 1) * MODROW], w2 = wp[(size_t)(4 * k4 + 2) * MODROW], w3 = wp[(size_t)(4 * k4 + 3) * MODROW];
#pragma unroll
                    for (int j = 0; j < NB; ++j) { const f32x4 s = *(const LAS f32x4*)(s_silu + j * 1024 + 128 * wid + 4 * k4); acc[j] += (s[0] * w0 + s[1] * w1) + (s[2] * w2 + s[3] * w3); }
                }
#pragma unroll
                for (int j = 0; j < NB; ++j) red[(wid * NB + j) * 64 + lane] = acc[j];
                __syncthreads();
                for (int idx = tid; idx < NB * 64; idx += 512) { const int j = idx >> 6, ln = idx & 63; float s = 0.f;
#pragma unroll
                    for (int w = 0; w < 8; ++w) s += red[(w * NB + j) * 64 + ln];
                    MOD[((size_t)l * NB + j) * MODROW + chunk * 64 + ln] = s + mod_b[l * MODROW + chunk * 64 + ln]; }
                __syncthreads();
            }
        }
        __syncthreads();
        {
            LAS float* scr = (LAS float*)(lds + wid * 8704);
            constexpr int I_W1 = 16 * 128, I_W2 = 64 * 32, I_SQ = 16 * 32, I_QKV = 16 * 96, I_DOWN = 16 * 13, I_UQ = 4 * 48, I_UKV = 2 * 64;
            constexpr int NITEMS = 4 * I_W1 + 4 * I_W2 + 2 * I_SQ + I_QKV + I_SQ + I_DOWN + I_UQ + I_UKV + I_SQ;
            for (int it = gw; it < NITEMS; it += ngw) {
                int r = it;
                if (r < 4 * I_W1) { const int l = r / I_W1; transpose_item(a.in[9] + (size_t)l * D * DFF, D, DFF, W1T + (size_t)l * D * DFF, 0, nullptr, scr, r % I_W1, lane); continue; } r -= 4 * I_W1;
                if (r < 4 * I_W2) { const int l = r / I_W2; transpose_item(a.in[10] + (size_t)l * D * DFF, DFF, D, W2T + (size_t)l * D * DFF, 0, nullptr, scr, r % I_W2, lane); continue; } r -= 4 * I_W2;
                if (r < 2 * I_SQ) { const int l = r / I_SQ; transpose_item(a.in[11] + (size_t)l * D * D, D, D, FWT + (size_t)l * D * D, 2, nullptr, scr, r % I_SQ, lane); continue; } r -= 2 * I_SQ;
                if (r < I_QKV) { transpose_item(a.in[13], D, 3 * D, DQKV, 0, nullptr, scr, r, lane); continue; } r -= I_QKV;
                if (r < I_SQ) { transpose_item(a.in[19], D, D, DWO, 0, nullptr, scr, r, lane); continue; } r -= I_SQ;
                if (r < I_DOWN) { transpose_item(a.in[20], D, 416, MDOWN, 0, nullptr, scr, r, lane); continue; } r -= I_DOWN;
                if (r < I_UQ) { transpose_item(a.in[23], 256, 1536, MUQ, 0, a.in[21], scr, r, lane); continue; } r -= I_UQ;
                if (r < I_UKV) { transpose_item(a.in[24], 128, 2048, MUKV, 1, a.in[22], scr, r, lane); continue; } r -= I_UKV;
                transpose_item(a.in[25], D, D, MWO, 0, nullptr, scr, r, lane);
            }
        }
        for (size_t i = gtid; i < (size_t)96 * 1024 / 8; i += gthreads) *(u32x4*)(MDOWN + (size_t)416 * 1024 + i * 8) = (u32x4){0u, 0u, 0u, 0u};
        for (size_t i = gtid; i < (size_t)NTOK * 2 / 4; i += gthreads) *(f32x4*)(SSQ + i * 4) = (f32x4){0.f, 0.f, 0.f, 0.f};
        for (size_t chn = gtid; chn < (size_t)4096 * 2048 / 8; chn += gthreads) {
            const int r = (int)(chn >> 8), s0 = (int)(chn & 255) * 8; const bool sinb = r >= 2048; const int k = r & 2047; float v[8];
#pragma unroll
            for (int j = 0; j < 8; ++j) { const float rev = (float)((k * (s0 + j)) & 4095) * (1.f / 4096.f); v[j] = sinb ? __builtin_amdgcn_sinf(rev) : __builtin_amdgcn_cosf(rev); }
            u32x4 w; w.x = pk2(v[0], v[1]); w.y = pk2(v[2], v[3]); w.z = pk2(v[4], v[5]); w.w = pk2(v[6], v[7]);
            *(u32x4*)(DFT4K + (size_t)r * 2048 + s0) = w;
        }
        for (size_t i = gtid; i < (size_t)BATCH * D; i += gthreads) NYQ[i] = 0.f;
        for (size_t chn = gtid; chn < (size_t)512 * 256 / 8; chn += gthreads) {
            const int r = (int)(chn >> 5), s0 = (int)(chn & 31) * 8, k = r & 255, part = r >> 8; float v[8];
#pragma unroll
            for (int j = 0; j < 8; ++j) { const float rev = (float)((k * (s0 + j)) & 255) * (1.f / 256.f); v[j] = part ? __builtin_amdgcn_sinf(rev) : __builtin_amdgcn_cosf(rev); }
            u32x4 w; w.x = pk2(v[0], v[1]); w.y = pk2(v[2], v[3]); w.z = pk2(v[4], v[5]); w.w = pk2(v[6], v[7]);
            *(u32x4*)(DFT256 + (size_t)r * 256 + s0) = w;
        }
        if (blockIdx.x == (unsigned)(G - 1)) {
            for (int i = tid; i < 1024; i += 512) { const int p = i >> 4, f = i & 15; const float inv = exp2f(-(float)f * (13.287712379549449f / 16.f));
                const float rev = ((float)p * inv) * 0.15915494309189535f; ropeDc[i] = __builtin_amdgcn_cosf(rev); ropeDs[i] = __builtin_amdgcn_sinf(rev); }
            { const int i = tid; const int p = i >> 3, f = i & 7; const float inv = exp2f(-(float)f * (13.287712379549449f / 8.f));
                const float rev = ((float)p * inv) * 0.15915494309189535f; ropeMc[i] = __builtin_amdgcn_cosf(rev); ropeMs[i] = __builtin_amdgcn_sinf(rev); }
            if (tid == 0) { float s1 = 0.f, s2 = 0.f; for (int i = 0; i < 64; ++i) { s1 += a.in[14][i] * a.in[15][i]; s2 += a.in[16][i] * a.in[17][i]; }
                lamp[0] = expf(s1) - expf(s2) + LAM_INIT; }
        }
    }
    cg::this_grid().sync();
    const XcdBarrier xbar = xcd_barrier_post(BARW, (volatile LAS unsigned*)(lds + LDS_BYTES - 16));

    { EpiFw E{FMW}; GEMM_CALL(EpiFw, FWT, DFT256, 8192, 512, 256, 256, 256, 0, E); }

#pragma unroll 1
    for (int l = 0; l < DEPTH; ++l) {
        const int kind = l % 3; const bool wctx = l < DEPTH - 1; const int nrows = wctx ? NTOK : NLAT;
        const float* MODl = MOD + (size_t)l * NB * MODROW;
        const float* xl = (l == 0) ? x_in : out; const float* xc = (l == 0) ? ctx_in : XC;
        if (kind == 0) norm_rows_T(lds, xl, xc, nrows, norm_mix_g + l * D, MODl, 0, 1024, H, HN, NYQ);
        else norm_rows(xl, xc, nrows, norm_mix_g + l * D, MODl, 0, 1024, H, PART, XC);
        xcd_barrier(xbar);
        const bf16_t* Afin; const bf16_t* Wfin; int Kfin; const float* biasfin = nullptr;
        if (kind == 0) {
            const int j = l / 3;
            { const int ftid = fresh_tid();
              for (int i = blockIdx.x * 512 + ftid; i < BATCH * D; i += G * 512) { const int bb = i >> 10, d = i & 1023;
                  BIG[(size_t)(bb * SEQ + SEQ / 2) * 2048 + d] = f2bf(NYQ[i] + HN[i]); NYQ[i] = 0.f; } }
#pragma unroll 1
            for (int pass = 0; pass < (wctx ? 3 : 2); ++pass) {
                const bool cx = pass == 2; const int S_ = cx ? CTX : SEQ;
                EpiDft E{BIG, S_, cx ? 8 : 12, cx ? NLAT : 0, cx ? 0 : pass + 1, HN};
                const bf16_t* A_ = cx ? DFT256 : DFT4K + (size_t)pass * 2048 * 2048;
                const bf16_t* B_ = cx ? H + (size_t)NLAT * D : H + (size_t)pass * BATCH * D * 2048;
                const int M_ = cx ? 2 * CTX : 2048, K_ = cx ? CTX : 2048;
                GEMM_CALL(EpiDft, A_, B_, M_, 16384, K_, K_, K_, 0, E);
            }
            xcd_barrier(xbar);
            Afin = BIG; Wfin = FMW + (size_t)j * 1024 * 2048; Kfin = 2048; biasfin = a.in[12] + j * D;
        } else if (kind == 1) {
            bf16_t* Qb = BIG; bf16_t* Kb = BIG + (size_t)NTOK * D; bf16_t* VT = BIG + (size_t)2 * NTOK * D;
            { EpiDiffQK E{Qb, Kb, ropeDc, ropeDs, 0.125f * LOG2E}; GEMM_CALL(EpiDiffQK, H, DQKV, nrows, 2048, 1024, 1024, 1024, 0, E); }
            { EpiVt E{VT, nullptr}; GEMM_CALL(EpiVt, DQKV + (size_t)2048 * D, H, 1024, nrows, 1024, 1024, 1024, 128, E); }
            xcd_barrier(xbar);
            { const float lam = lamp[0]; const int nlat_u = BATCH * 8 * 32, nctx_u = wctx ? BATCH * 8 * 2 : 0;
              for (int u = blockIdx.x; u < nlat_u + nctx_u; u += G) {
                  int qrow0, b, h, nt;
                  if (u < nlat_u) { int qb = u & 31, bh = u >> 5;
                      if (G == 256) { const int it = u >> 8; bh = it * 8 + (blockIdx.x & 7); qb = blockIdx.x >> 3; }
                      b = bh >> 3; h = bh & 7; qrow0 = b * SEQ + qb * 128; nt = KVLEN / 64; }
                  else { const int uu = u - nlat_u, qb = uu & 1, bh = uu >> 1; b = bh >> 3; h = bh & 7; qrow0 = NLAT + b * CTX + qb * 128; nt = CTX / 64; }
                  attn_diff_unit(lds, Qb, Kb, VT, H, qrow0, b, h, nt, lam, a.in[18]);
              } }
            xcd_barrier(xbar);
            Afin = H; Wfin = DWO; Kfin = 1024;
        } else {
            bf16_t* QM = BIG; bf16_t* Kb = BIG + (size_t)NTOK * 1536; bf16_t* VT = Kb + (size_t)NTOK * D;
            { EpiMlaDown E{CQ, KR, SSQ, ropeMc, ropeMs}; GEMM_CALL(EpiMlaDown, H, MDOWN, nrows, 512, 1024, 1024, 1024, 0, E); }
            xcd_barrier(xbar);
            { EpiMlaQ E{QM, SSQ, ropeMc, ropeMs, 0.10206207261596577f * LOG2E}; GEMM_CALL(EpiMlaQ, CQ, MUQ, nrows, 1536, 256, 512, 256, 0, E); }
            { EpiMlaK E{Kb, SSQ}; GEMM_CALL(EpiMlaK, CQ + 256, MUKV, nrows, 1024, 128, 512, 128, 96, E); }
            { EpiVt E{VT, SSQ}; GEMM_CALL(EpiVt, MUKV + (size_t)1024 * 128, CQ + 256, 1024, nrows, 128, 128, 512, 160, E); }
            xcd_barrier(xbar);
            { const int nlat_u = BATCH * 16 * 16, nctx_u = wctx ? BATCH * 16 : 0;
              for (int u = blockIdx.x; u < nlat_u + nctx_u; u += G) {
                  int qrow0, b, h, nt;
                  if (u < nlat_u) { int qb = u & 15, bh = u >> 4;
                      if (G == 256) { const int it = u >> 8, sl = blockIdx.x >> 3; bh = (it * 8 + (blockIdx.x & 7)) * 2 + (sl >> 4); qb = sl & 15; }
                      b = bh >> 4; h = bh & 15; qrow0 = b * SEQ + qb * 256; nt = KVLEN / 64; }
                  else { const int bh = u - nlat_u; b = bh >> 4; h = bh & 15; qrow0 = NLAT + b * CTX; nt = CTX / 64; }
                  attn_mla_unit(lds, QM, Kb, KR, VT, H, qrow0, b, h, nt);
              } }
            xcd_barrier(xbar);
            Afin = H; Wfin = MWO; Kfin = 1024;
        }
        { EpiResid E{xl, xc, out, XC, MODl + 2048, biasfin}; GEMM_CALL(EpiResid, Afin, Wfin, NLAT, 1024, Kfin, Kfin, Kfin, 0, E); }
        if (wctx) {
            { EpiResidPart E{PART, MODl + 2048, biasfin};
              pg8::Gemm gg__{Afin + (size_t)NLAT * Kfin, Wfin, 4 * NCTX, 1024, Kfin / 4, Kfin, Kfin}; pg8::PartOrder so__; so__.init(4 * NCTX, 1024, G, (int)blockIdx.x);
              pg8::gemm_phase<EpiResidPart, pg8::PartOrder, true, true>(lds, gg__, so__, E); }
        }
        xcd_barrier(xbar);
        norm_rows(out, xc, nrows, norm_mlp_g + l * D, MODl, 3072, 4096, H, wctx ? PART : nullptr, XC);
        xcd_barrier(xbar);
        { EpiRelu2 E{BIG, DFF}; GEMM_CALL(EpiRelu2, H, W1T + (size_t)l * D * DFF, nrows, DFF, 1024, 1024, 1024, 0, E); }
        xcd_barrier(xbar);
        { EpiResid E{out, XC, out, XC, MODl + 5120, nullptr}; GEMM_CALL(EpiResid, BIG, W2T + (size_t)l * D * DFF, NLAT, 1024, DFF, DFF, DFF, 0, E); }
        if (wctx) {
            { EpiResidPart E{PART, MODl + 5120, nullptr};
              pg8::Gemm gg__{BIG + (size_t)NLAT * DFF, W2T + (size_t)l * D * DFF, 4 * NCTX, 1024, DFF / 4, DFF, DFF}; pg8::PartOrder so__; so__.init(4 * NCTX, 1024, G, (int)blockIdx.x);
              pg8::gemm_phase<EpiResidPart, pg8::PartOrder, true, true>(lds, gg__, so__, E); }
        }
        xcd_barrier(xbar);
    }
    const int ftid = fresh_tid(), lane = ftid & 63, gw = blockIdx.x * NWAVES + __builtin_amdgcn_readfirstlane(ftid >> 6), ngw = G * NWAVES;
    for (int row_ = gw; row_ < NLAT; row_ += ngw) { const int row = NLAT - 1 - row_;
        float* xp = out + (size_t)row * D; f32x4 v[4]; float ss = 0.f;
#pragma unroll
        for (int j = 0; j < 4; ++j) { v[j] = *(const f32x4*)(xp + j * 256 + lane * 4); ss += dot4(v[j]); }
        ss = wave_sum(ss); const float rstd = rsqrtf(ss * (1.f / 1024.f) + EPS);
#pragma unroll
        for (int j = 0; j < 4; ++j) { const f32x4 gv = *(const f32x4*)(final_g + j * 256 + lane * 4); *(f32x4*)(xp + j * 256 + lane * 4) = v[j] * rstd * gv; }
    }
}
}

extern "C" void kernel_launch(void* const* d_in, const int* in_sizes, int n_in, void* d_out, int out_size, void* d_ws, size_t ws_size, hipStream_t stream) {
    constexpr size_t kDynLds = mk::LDS_BYTES;
    static int grid_blocks = 0;
    if (!grid_blocks) {
        int dev = 0, cus = 0, per_cu = 0;
        (void)hipGetDevice(&dev);
        (void)hipDeviceGetAttribute(&cus, hipDeviceAttributeMultiprocessorCount, dev);
        (void)hipFuncSetAttribute((const void*)mk::fwd_megakernel, hipFuncAttributeMaxDynamicSharedMemorySize, (int)kDynLds);
        (void)hipOccupancyMaxActiveBlocksPerMultiprocessor(&per_cu, (const void*)mk::fwd_megakernel, 512, kDynLds);
        if (per_cu < 1) per_cu = 1;
        grid_blocks = cus * per_cu;
        if (n_in != 26 || ws_size < mk::WS_END) fprintf(stderr, "kernel_launch: unexpected n_in %d / ws_size %zu\n", n_in, ws_size);
    }
    mk::Args a{};
    for (int i = 0; i < 26; ++i) a.in[i] = (const float*)d_in[i];
    a.out = (float*)d_out; a.ws = (unsigned char*)d_ws;
    void* args[] = {&a};
    hipError_t e = hipLaunchCooperativeKernel((const void*)mk::fwd_megakernel, dim3(grid_blocks), dim3(512), args, kDynLds, stream);
    if (e != hipSuccess) fprintf(stderr, "cooperative launch failed: %s (grid %d)\n", hipGetErrorString(e), grid_blocks);
}
```

```cpp
#include <hip/hip_runtime.h>
#include <hip/hip_cooperative_groups.h>
#include <cstdio>
#include <cstdint>
namespace cg = cooperative_groups;
namespace pg8 {
#define PG8_LAS __attribute__((address_space(3)))
typedef unsigned short bf16_t;
typedef short bf16x8 __attribute__((ext_vector_type(8)));
typedef float f32x4 __attribute__((ext_vector_type(4)));
typedef unsigned u32x4 __attribute__((ext_vector_type(4)));
constexpr int BM = 256, BK = 64, HALF = 128, HTB = HALF * BK * 2  , STAGE_BYTES = 8 * HTB, NXCD = 8, WGM = 8;

__host__ __device__ __forceinline__ int lds_byte(int r, int c) { const int st = (r >> 4) * 2 + (c >> 5), rr = r & 15, cc = c & 31, ob = rr * 64 + cc * 2; return st * 1024 + (ob ^ (((ob >> 9) & 1) << 5)); }
__host__ __device__ __forceinline__ void stage_rc(int b, int& R, int& C) { const int st = b / 1024, sb = b % 1024, swz = sb ^ (((sb >> 9) & 1) << 5); R = (st >> 1) * 16 + swz / 64; C = (st & 1) * 32 + (swz % 64) / 2; }
__host__ __device__ __forceinline__ int perm32(int rho) { const int n = rho >> 4, i = rho & 15; return 8 * (i >> 2) + 4 * n + (i & 3); }

struct Unit { int pm, pn; };
struct Gemm { const bf16_t* A; const bf16_t* Bt; int M, N, K, lda, ldb; };

struct StaticOrder {
    int nM, nN, nwg, G, c;
    __host__ __device__ void init(int M, int N, int G_, int c_) { nM = M / BM; nN = N / BM; nwg = nM * nN; G = G_; c = c_; }
    __host__ __device__ bool next(int i, Unit& u) const {
        const long L = (long)i * G + c; if (L >= nwg) return false;
        int wgid = (int)L; { const int q = nwg / NXCD, r = nwg % NXCD, xcd = wgid % NXCD, off = wgid / NXCD; wgid = (xcd < r ? xcd * (q + 1) : r * (q + 1) + (xcd - r) * q) + off; }
        const int nig = WGM * nN, gid = wgid / nig, fm = gid * WGM, gsz = (nM - fm) < WGM ? (nM - fm) : WGM;
        u.pm = fm + ((wgid % nig) % gsz); u.pn = (wgid % nig) / gsz; return true;
    }
    __device__ __forceinline__ void a_ready(const Unit&) const {}
    __device__ __forceinline__ void done(const Unit&) const {}
    __device__ __forceinline__ size_t aoff(const Unit& u, size_t ts, int) const { return (size_t)u.pm * ts; }
    __device__ __forceinline__ size_t boff(const Unit& u, size_t ts, int) const { return (size_t)u.pn * ts; }
};
struct PartOrder : StaticOrder {
    __device__ __forceinline__ size_t aoff(const Unit& u, size_t ts, int K) const { return (size_t)(u.pm & 15) * ts + (size_t)(u.pm >> 4) * K * 2; }
    __device__ __forceinline__ size_t boff(const Unit& u, size_t ts, int K) const { return (size_t)u.pn * ts + (size_t)(u.pm >> 4) * K * 2; }
};


template <class Epi, class Sched, bool ALIGN_EPI = false, bool SP2 = false>
__device__ __forceinline__ void gemm_phase(PG8_LAS unsigned char* lds, const Gemm g, const Sched& S, const Epi& E) {
    int tid_l = threadIdx.x; asm volatile("" : "+v"(tid_l)); const int tid = tid_l, wid = __builtin_amdgcn_readfirstlane(tid >> 6), lane = tid & 63, wr = wid >> 2, wc = wid & 3, fr = lane & 15, fq = lane >> 4;
    int K_l = g.K; asm volatile("" : "+s"(K_l)); const int K = K_l, nt = K / BK;
    unsigned voffA[2], voffB[2];
#pragma unroll
    for (int i = 0; i < 2; ++i) { int R, C; stage_rc(tid * 16 + i * 8192, R, C); const int Rb = Epi::PERM ? ((R & ~31) + perm32(R & 31)) : R;
        voffA[i] = (unsigned)(R * g.lda + C) * 2u; voffB[i] = (unsigned)(Rb * g.ldb + C) * 2u; }
    const size_t kstep = (size_t)(BK * 2);
    const size_t hstepA = (size_t)HALF * g.lda * 2, hstepB = (size_t)HALF * g.ldb * 2;
    const size_t tstepA = 2 * hstepA, tstepB = 2 * hstepB;
    const unsigned ldsw = (unsigned)wid * 1024u;
    const int aoff = lds_byte(wr * 64 + fr, fq * 8), boff = lds_byte(wc * 32 + fr, fq * 8);
#define PG8_SA(b, h) (((b) * 2 + (h)) * HTB)
#define PG8_SB(b, h) ((4 + (b) * 2 + (h)) * HTB)
#define PG8_STAGE(bufoff, gbase, voff) do { _Pragma("unroll") for (int _i = 0; _i < 2; ++_i) \
        __builtin_amdgcn_global_load_lds((const unsigned*)((const char*)(gbase) + (voff)[_i]), (PG8_LAS unsigned*)(lds + (bufoff) + ldsw + _i * 8192), 16, 0, 0); } while (0)
#define PG8_LDA(dst, b, h) do { _Pragma("unroll") for (int m = 0; m < 4; ++m) _Pragma("unroll") for (int k = 0; k < 2; ++k) dst[m][k] = *(const PG8_LAS bf16x8*)(lds + PG8_SA(b, h) + aoff + m * 2048 + k * 1024); } while (0)
#define PG8_LDB(dst, b, h) do { _Pragma("unroll") for (int n = 0; n < 2; ++n) _Pragma("unroll") for (int k = 0; k < 2; ++k) dst[n][k] = *(const PG8_LAS bf16x8*)(lds + PG8_SB(b, h) + boff + n * 2048 + k * 1024); } while (0)
#define PG8_MMA(ai, bj, At, Bt) do { __builtin_amdgcn_s_setprio(1); _Pragma("unroll") for (int m = 0; m < 4; ++m) _Pragma("unroll") for (int n = 0; n < 2; ++n) _Pragma("unroll") for (int k = 0; k < 2; ++k) \
        acc[ai][bj][m][n] = __builtin_amdgcn_mfma_f32_16x16x32_bf16(Bt[n][k], At[m][k], acc[ai][bj][m][n], 0, 0, 0); __builtin_amdgcn_s_setprio(0); } while (0)
#define PG8_WAIT_V(n) asm volatile("s_waitcnt vmcnt(" #n ")" ::: "memory")
#define PG8_WAIT_L(n) asm volatile("s_waitcnt lgkmcnt(" #n ")" ::: "memory")
#define PG8_BAR __builtin_amdgcn_s_barrier()
#define PG8_SCHED __builtin_amdgcn_sched_barrier(0)
    Unit cur, nxt; int ui = 0;
    if (!S.next(0, cur)) return;
    f32x4 acc[2][2][4][2];
#pragma unroll
    for (int a = 0; a < 2; ++a)
#pragma unroll
        for (int b = 0; b < 2; ++b)
#pragma unroll
            for (int m = 0; m < 4; ++m)
#pragma unroll
                for (int n = 0; n < 2; ++n) acc[a][b][m][n] = (f32x4){0.f, 0.f, 0.f, 0.f};
    bf16x8 At[4][2], B0[2][2], B1[2][2];
    const char* cA = (const char*)g.A + S.aoff(cur, tstepA, K); const char* cB = (const char*)g.Bt + S.boff(cur, tstepB, K);
    S.a_ready(cur);
    if constexpr (SP2) {
        PG8_STAGE(PG8_SB(0, 0), cB, voffB); PG8_STAGE(PG8_SB(0, 1), cB + hstepB, voffB); PG8_STAGE(PG8_SA(0, 0), cA, voffA); PG8_STAGE(PG8_SA(0, 1), cA + hstepA, voffA);
        if (wr == 1) PG8_BAR;
        PG8_WAIT_V(2); PG8_BAR;
        PG8_STAGE(PG8_SB(1, 0), cB + kstep, voffB); PG8_STAGE(PG8_SA(1, 0), cA + kstep, voffA); PG8_STAGE(PG8_SB(1, 1), cB + hstepB + kstep, voffB);
        PG8_WAIT_V(6); PG8_BAR;
    } else {
        PG8_STAGE(PG8_SB(0, 0), cB, voffB); PG8_STAGE(PG8_SA(0, 0), cA, voffA); PG8_STAGE(PG8_SB(0, 1), cB + hstepB, voffB); PG8_STAGE(PG8_SA(0, 1), cA + hstepA, voffA);
        if (wr == 1) PG8_BAR;
        PG8_WAIT_V(4); PG8_BAR;
        PG8_STAGE(PG8_SB(1, 0), cB + kstep, voffB); PG8_STAGE(PG8_SA(1, 0), cA + kstep, voffA); PG8_STAGE(PG8_SB(1, 1), cB + hstepB + kstep, voffB);
        PG8_WAIT_V(6); PG8_BAR;
    }
    for (;;) {
        const bool has_next = S.next(ui + 1, nxt);
        const char* nA = has_next ? (const char*)g.A + S.aoff(nxt, tstepA, K) : cA; const char* nB = has_next ? (const char*)g.Bt + S.boff(nxt, tstepB, K) : cB;
        for (int t = 0; t < nt; t += 2) {
            const bool last = (t == nt - 2);
            const char* a1 = cA + (size_t)(t + 1) * kstep;
            const char* a2 = last ? nA : cA + (size_t)(t + 2) * kstep; const char* b2 = last ? nB : cB + (size_t)(t + 2) * kstep;
            const char* a3 = a2 + kstep; const char* b3 = b2 + kstep;
            if (last && has_next) S.a_ready(nxt);
            if constexpr (SP2) {
            PG8_LDB(B0, 0, 0); PG8_LDB(B1, 0, 1); PG8_SCHED; PG8_LDA(At, 0, 0); PG8_STAGE(PG8_SA(1, 1), a1 + hstepA, voffA);
            PG8_WAIT_V(8); PG8_WAIT_L(0); PG8_BAR; PG8_MMA(0, 0, At, B0); PG8_MMA(0, 1, At, B1); PG8_BAR; PG8_SCHED;
            PG8_LDA(At, 0, 1); PG8_STAGE(PG8_SB(0, 0), b2, voffB); PG8_STAGE(PG8_SB(0, 1), b2 + hstepB, voffB); PG8_STAGE(PG8_SA(0, 0), a2, voffA);
            PG8_WAIT_V(8); PG8_WAIT_L(0); PG8_BAR; PG8_MMA(1, 0, At, B0); PG8_MMA(1, 1, At, B1); PG8_BAR; PG8_SCHED;
            PG8_LDB(B0, 1, 0); PG8_LDB(B1, 1, 1); PG8_SCHED; PG8_LDA(At, 1, 0); PG8_STAGE(PG8_SA(0, 1), a2 + hstepA, voffA);
            PG8_WAIT_V(8); PG8_WAIT_L(0); PG8_BAR; PG8_MMA(0, 0, At, B0); PG8_MMA(0, 1, At, B1); PG8_BAR; PG8_SCHED;
            PG8_LDA(At, 1, 1); PG8_STAGE(PG8_SB(1, 0), b3, voffB); PG8_STAGE(PG8_SB(1, 1), b3 + hstepB, voffB); PG8_STAGE(PG8_SA(1, 0), a3, voffA);
            PG8_WAIT_V(8); PG8_WAIT_L(0); PG8_BAR; PG8_MMA(1, 0, At, B0); PG8_MMA(1, 1, At, B1); PG8_BAR; PG8_SCHED;
            } else {
            PG8_LDB(B0, 0, 0); PG8_SCHED; PG8_LDA(At, 0, 0); PG8_STAGE(PG8_SA(1, 1), a1 + hstepA, voffA);
            PG8_WAIT_L(8); PG8_BAR; PG8_WAIT_L(0); PG8_MMA(0, 0, At, B0); PG8_BAR; PG8_SCHED;
            PG8_LDB(B1, 0, 1); PG8_STAGE(PG8_SB(0, 0), b2, voffB);
            PG8_BAR; PG8_WAIT_L(0); PG8_MMA(0, 1, At, B1); PG8_BAR;
            PG8_LDA(At, 0, 1); PG8_STAGE(PG8_SA(0, 0), a2, voffA);
            PG8_BAR; PG8_WAIT_L(0); PG8_MMA(1, 0, At, B0); PG8_BAR; PG8_SCHED;
            PG8_STAGE(PG8_SB(0, 1), b2 + hstepB, voffB);
            PG8_WAIT_V(6); PG8_BAR; PG8_MMA(1, 1, At, B1); PG8_BAR;
            PG8_LDB(B0, 1, 0); PG8_SCHED; PG8_LDA(At, 1, 0); PG8_STAGE(PG8_SA(0, 1), a2 + hstepA, voffA);
            PG8_WAIT_L(8); PG8_BAR; PG8_WAIT_L(0); PG8_MMA(0, 0, At, B0); PG8_BAR; PG8_SCHED;
            PG8_LDB(B1, 1, 1); PG8_STAGE(PG8_SB(1, 0), b3, voffB);
            PG8_BAR; PG8_WAIT_L(0); PG8_MMA(0, 1, At, B1); PG8_BAR;
            PG8_LDA(At, 1, 1); PG8_STAGE(PG8_SA(1, 0), a3, voffA);
            PG8_BAR; PG8_WAIT_L(0); PG8_MMA(1, 0, At, B0); PG8_BAR; PG8_SCHED;
            PG8_STAGE(PG8_SB(1, 1), b3 + hstepB, voffB);
            PG8_WAIT_V(6); PG8_BAR; PG8_MMA(1, 1, At, B1); PG8_BAR;
            }
        }
        if constexpr (ALIGN_EPI) { if (wr == 0) PG8_BAR; }
        if constexpr (!Epi::AFTER_DRAIN) { Unit ce = cur; int fr_ = fr, fq_ = fq; asm volatile("" : "+s"(ce.pm), "+s"(ce.pn), "+v"(fr_), "+v"(fq_)); E(acc, ce, wr, wc, fr_, fq_); S.done(cur); }
        if (!has_next) break;
#pragma unroll
        for (int a = 0; a < 2; ++a)
#pragma unroll
            for (int b = 0; b < 2; ++b)
#pragma unroll
                for (int m = 0; m < 4; ++m)
#pragma unroll
                    for (int n = 0; n < 2; ++n) acc[a][b][m][n] = (f32x4){0.f, 0.f, 0.f, 0.f};
        cur = nxt; cA = nA; cB = nB; ++ui;
        if constexpr (ALIGN_EPI) { if (wr == 1) PG8_BAR; }
    }
    PG8_WAIT_V(0);
    if constexpr (!ALIGN_EPI) { if (wr == 0) PG8_BAR; }
    PG8_BAR;
    if constexpr (Epi::AFTER_DRAIN) { E.fused(acc, cur, wr, wc, fr, fq, lds, wid, lane); S.done(cur); }
#undef PG8_SA
#undef PG8_SB
#undef PG8_STAGE
#undef PG8_LDA
#undef PG8_LDB
#undef PG8_MMA
#undef PG8_WAIT_V
#undef PG8_WAIT_L
#undef PG8_BAR
#undef PG8_SCHED
}
}


namespace mk {
using pg8::bf16_t; using pg8::bf16x8; using pg8::f32x4; using pg8::u32x4;
#define LAS __attribute__((address_space(3)))
typedef short s16x4 __attribute__((ext_vector_type(4)));
typedef float f32x16 __attribute__((ext_vector_type(16)));
typedef unsigned u32x2 __attribute__((ext_vector_type(2)));
typedef float f32x2_t __attribute__((ext_vector_type(2)));
typedef __bf16 bf16x2_t __attribute__((ext_vector_type(2)));

constexpr int D = 1024, BATCH = 16, SEQ = 4096, CTX = 256, DFF = 4096, DEPTH = 4;
constexpr int NLAT = BATCH * SEQ, NCTX = BATCH * CTX, NTOK = NLAT + NCTX, KVLEN = CTX + SEQ, NB = BATCH + 1;
constexpr float EPS = 1e-6f;
constexpr float LOG2E = 1.4426950408889634f;
constexpr float LAM_INIT = 0.35550907f;
constexpr int MODROW = 6 * D;
constexpr int NWAVES = 8;
constexpr int LDS_BYTES = 143360;

constexpr size_t MiB = (size_t)1 << 20;
constexpr size_t WS_MOD = 0, WS_ROPE = 2 * MiB, WS_SSQ = 3 * MiB, WS_W1T = 4 * MiB, WS_W2T = 36 * MiB, WS_DQKV = 68 * MiB, WS_DWO = 74 * MiB,
                 WS_MDOWN = 76 * MiB, WS_MUQ = 77 * MiB, WS_MUKV = 78 * MiB, WS_MWO = 79 * MiB, WS_FWT = 81 * MiB, WS_FMW = 85 * MiB, WS_DFT256 = 93 * MiB,
                 WS_DFT4K = 94 * MiB, WS_XC = 158 * MiB, WS_H = 174 * MiB, WS_CQ = 310 * MiB, WS_KR = 378 * MiB, WS_BIG = 384 * MiB, WS_PART = 928 * MiB, WS_END = 992 * MiB;

__device__ __forceinline__ unsigned pk2(float lo, float hi) { f32x2_t v = {lo, hi}; bf16x2_t b = __builtin_convertvector(v, bf16x2_t); return __builtin_bit_cast(unsigned, b); }
__device__ __forceinline__ u32x2 pk4(f32x4 v) { u32x2 r; r.x = pk2(v[0], v[1]); r.y = pk2(v[2], v[3]); return r; }
__device__ __forceinline__ u32x4 pk8(f32x4 a, f32x4 b) { u32x4 r; r.x = pk2(a[0], a[1]); r.y = pk2(a[2], a[3]); r.z = pk2(b[0], b[1]); r.w = pk2(b[2], b[3]); return r; }
__device__ __forceinline__ unsigned short f2bf(float f) { unsigned u = __builtin_bit_cast(unsigned, f); return (unsigned short)((u + 0x7fffu + ((u >> 16) & 1u)) >> 16); }
__device__ __forceinline__ float wave_sum(float v) {
#pragma unroll
    for (int o = 1; o < 64; o <<= 1) v += __shfl_xor(v, o);
    return v;
}
__device__ __forceinline__ int kvrow_of(int r) { if (r < NLAT) return (r >> 12) * KVLEN + CTX + (r & 4095); const int rr = r - NLAT; return (rr >> 8) * KVLEN + (rr & 255); }
__device__ __forceinline__ f32x4 shfl_xor4(f32x4 v, int m) { f32x4 r; r[0] = __shfl_xor(v[0], m); r[1] = __shfl_xor(v[1], m); r[2] = __shfl_xor(v[2], m); r[3] = __shfl_xor(v[3], m); return r; }
__device__ __forceinline__ float dot4(f32x4 v) { return (v[0] * v[0] + v[1] * v[1]) + (v[2] * v[2] + v[3] * v[3]); }

typedef const f32x4 (&AccRef)[2][2][4][2];
__device__ __forceinline__ int fresh_tid() { int t = threadIdx.x; asm volatile("" : "+v"(t)); return t; }

struct EpiResid {
    static constexpr bool PERM = true, AFTER_DRAIN = false;
    const float* base_lat; const float* base_ctx; float* out_lat; float* out_ctx; const float* gate; const float* bias;
    __device__ __forceinline__ void operator()(AccRef acc, const pg8::Unit& u, int wr, int wc, int fr, int fq) const {
        const int row0 = u.pm * 256; const bool isctx = row0 >= NLAT;
        const int bidx = isctx ? BATCH : (row0 >> 12);
        const float* gp = gate + bidx * MODROW;
        const float* bp = isctx ? base_ctx : base_lat; float* op = isctx ? out_ctx : out_lat;
        const int rbase = (isctx ? row0 - NLAT : row0) + wr * 64 + fr;
        const int cbase = u.pn * 256 + wc * 32 + fq * 8;
#pragma unroll
        for (int bj = 0; bj < 2; ++bj) {
            const int col = cbase + bj * 128;
            const f32x4 g0 = *(const f32x4*)(gp + col), g1 = *(const f32x4*)(gp + col + 4);
            f32x4 b0 = {0.f, 0.f, 0.f, 0.f}, b1 = {0.f, 0.f, 0.f, 0.f}; if (bias) { b0 = *(const f32x4*)(bias + col); b1 = *(const f32x4*)(bias + col + 4); }
#pragma unroll
            for (int ai = 0; ai < 2; ++ai)
#pragma unroll
                for (int m = 0; m < 4; ++m) {
                    const size_t off = (size_t)(rbase + ai * 128 + m * 16) * D + col;
                    const f32x4 x0 = *(const f32x4*)(bp + off), x1 = *(const f32x4*)(bp + off + 4);
                    *(f32x4*)(op + off) = x0 + g0 * (acc[ai][bj][m][0] + b0);
                    *(f32x4*)(op + off + 4) = x1 + g1 * (acc[ai][bj][m][1] + b1);
                }
        }
    }
};
struct EpiResidPart {
    static constexpr bool PERM = true, AFTER_DRAIN = false;
    float* part0; const float* gate; const float* bias0;
    __device__ __forceinline__ void operator()(AccRef acc, const pg8::Unit& u, int wr, int wc, int fr, int fq) const {
        const float* gp = gate + BATCH * MODROW; const int pt = u.pm >> 4; float* part = part0 + (size_t)pt * NCTX * D; const float* bias = pt == 0 ? bias0 : nullptr;
        const int rbase = (u.pm & 15) * 256 + wr * 64 + fr, cbase = u.pn * 256 + wc * 32 + fq * 8;
#pragma unroll
        for (int bj = 0; bj < 2; ++bj) {
            const int col = cbase + bj * 128;
            const f32x4 g0 = *(const f32x4*)(gp + col), g1 = *(const f32x4*)(gp + col + 4);
            f32x4 b0 = {0.f, 0.f, 0.f, 0.f}, b1 = {0.f, 0.f, 0.f, 0.f}; if (bias) { b0 = *(const f32x4*)(bias + col); b1 = *(const f32x4*)(bias + col + 4); }
#pragma unroll
            for (int ai = 0; ai < 2; ++ai)
#pragma unroll
                for (int m = 0; m < 4; ++m) {
                    const size_t off = (size_t)(rbase + ai * 128 + m * 16) * D + col;
                    *(f32x4*)(part + off) = g0 * (acc[ai][bj][m][0] + b0); *(f32x4*)(part + off + 4) = g1 * (acc[ai][bj][m][1] + b1);
                }
        }
    }
};
struct EpiRelu2 {
    static constexpr bool PERM = true, AFTER_DRAIN = false;
    bf16_t* O; int ldc;
    __device__ __forceinline__ void operator()(AccRef acc, const pg8::Unit& u, int wr, int wc, int fr, int fq) const {
        bf16_t* base = O + (size_t)(u.pm * 256 + wr * 64 + fr) * ldc + u.pn * 256 + wc * 32 + 8 * fq;
#pragma unroll
        for (int ai = 0; ai < 2; ++ai)
#pragma unroll
            for (int m = 0; m < 4; ++m) { bf16_t* rowp = base + (size_t)(ai * 128 + m * 16) * ldc;
#pragma unroll
                for (int bj = 0; bj < 2; ++bj) { f32x4 v0 = acc[ai][bj][m][0], v1 = acc[ai][bj][m][1];
#pragma unroll
                    for (int j = 0; j < 4; ++j) { float a = fmaxf(v0[j], 0.f), b = fmaxf(v1[j], 0.f); v0[j] = a * a; v1[j] = b * b; }
                    *(u32x4*)(rowp + bj * 128) = pk8(v0, v1); } }
    }
};
struct EpiDft {
    static constexpr bool PERM = true, AFTER_DRAIN = false;
    bf16_t* G; int S, lgS, rowbase, mode; const float* hN;
    __device__ __forceinline__ void operator()(AccRef acc, const pg8::Unit& u, int wr, int wc, int fr, int fq) const {
        const int r0 = u.pm * 256, c0 = u.pn * 256, b = c0 >> 10, colo = (c0 & 1023) + wc * 32 + 8 * fq;
        if (mode == 0) {
            const int part = r0 >> lgS, k0 = r0 & (S - 1);
            bf16_t* base = G + (size_t)(rowbase + b * S + k0 + wr * 64 + fr) * 2048 + part * 1024 + colo;
#pragma unroll
            for (int ai = 0; ai < 2; ++ai)
#pragma unroll
                for (int m = 0; m < 4; ++m) { bf16_t* rowp = base + (size_t)(ai * 128 + m * 16) * 2048;
#pragma unroll
                    for (int bj = 0; bj < 2; ++bj) *(u32x4*)(rowp + bj * 128) = pk8(acc[ai][bj][m][0], acc[ai][bj][m][1]); }
        } else {
            bf16_t* Gb = G + (size_t)(rowbase + b * 4096) * 2048 + colo; const int ccol = c0 + wc * 32 + 8 * fq;
#pragma unroll
            for (int bj = 0; bj < 2; ++bj) {
                f32x4 h0 = {0.f, 0.f, 0.f, 0.f}, h1 = h0;
                if (mode == 1) { h0 = *(const f32x4*)(hN + ccol + bj * 128); h1 = *(const f32x4*)(hN + ccol + bj * 128 + 4); }
#pragma unroll
                for (int ai = 0; ai < 2; ++ai)
#pragma unroll
                    for (int m = 0; m < 4; ++m) {
                        const int k = r0 + ai * 128 + wr * 64 + m * 16 + fr;
                        if (mode == 1) {
                            const float sg = (k & 1) ? -1.f : 1.f; const u32x4 w = pk8(acc[ai][bj][m][0] + h0 * sg, acc[ai][bj][m][1] + h1 * sg);
                            *(u32x4*)(Gb + (size_t)k * 2048 + bj * 128) = w; if (k != 0) *(u32x4*)(Gb + (size_t)(4096 - k) * 2048 + bj * 128) = w;
                        } else {
                            const f32x4 v0 = acc[ai][bj][m][0], v1 = acc[ai][bj][m][1];
                            if (k == 0) { *(u32x4*)(Gb + 1024 + bj * 128) = (u32x4){0u, 0u, 0u, 0u}; *(u32x4*)(Gb + (size_t)2048 * 2048 + 1024 + bj * 128) = (u32x4){0u, 0u, 0u, 0u}; }
                            else { *(u32x4*)(Gb + (size_t)k * 2048 + 1024 + bj * 128) = pk8(v0, v1); *(u32x4*)(Gb + (size_t)(4096 - k) * 2048 + 1024 + bj * 128) = pk8(-v0, -v1); }
                        }
                    }
            }
        }
    }
};
struct EpiFw {
    static constexpr bool PERM = true, AFTER_DRAIN = false;
    bf16_t* FMW;
    __device__ __forceinline__ void operator()(AccRef acc, const pg8::Unit& u, int wr, int wc, int fr, int fq) const {
        const float sg = u.pn ? (-1.f / 1024.f) : (1.f / 1024.f);
        const int r0 = u.pm * 256, jg = r0 >> 10, j = jg >> 2, g = jg & 3, n0 = r0 & 1023;
        bf16_t* base = FMW + (size_t)j * 1024 * 2048 + (size_t)(n0 + wr * 64 + fr) * 2048 + (u.pn ? 1024 : 0) + g * 256 + wc * 32 + 8 * fq;
#pragma unroll
        for (int ai = 0; ai < 2; ++ai)
#pragma unroll
            for (int m = 0; m < 4; ++m) { bf16_t* rowp = base + (size_t)(ai * 128 + m * 16) * 2048;
#pragma unroll
                for (int bj = 0; bj < 2; ++bj) *(u32x4*)(rowp + bj * 128) = pk8(acc[ai][bj][m][0] * sg, acc[ai][bj][m][1] * sg); }
    }
};
struct EpiDiffQK {
    static constexpr bool PERM = true, AFTER_DRAIN = false;
    bf16_t* Q; bf16_t* Kb; const float* rc; const float* rs; float qscale;
    __device__ __forceinline__ void operator()(AccRef acc, const pg8::Unit& u, int wr, int wc, int fr, int fq) const {
        const int row0 = u.pm * 256; const bool isctx = row0 >= NLAT; const bool isK = u.pn >= 4;
        const int colbase = (u.pn & 3) * 256 + wc * 32 + fq * 8;
        const float sc = isK ? 1.f : qscale; const float sgn = (fq < 2) ? -1.f : 1.f;
#pragma unroll
        for (int ai = 0; ai < 2; ++ai)
#pragma unroll
            for (int m = 0; m < 4; ++m) {
                const int r = row0 + ai * 128 + wr * 64 + m * 16 + fr;
                const int s = r & 4095, p = (wc & 1) ? (s & 63) : (s >> 6);
                f32x4 cs0 = {1.f, 1.f, 1.f, 1.f}, cs1 = cs0, sn0 = {0.f, 0.f, 0.f, 0.f}, sn1 = sn0;
                if (!isctx) { const float* cp = rc + p * 16 + (fq & 1) * 8; const float* sp = rs + p * 16 + (fq & 1) * 8;
                    cs0 = *(const f32x4*)cp; cs1 = *(const f32x4*)(cp + 4); sn0 = *(const f32x4*)sp * sgn; sn1 = *(const f32x4*)(sp + 4) * sgn; }
                const int drow = isK ? kvrow_of(r) : r;
                bf16_t* dp = (isK ? Kb : Q) + (size_t)drow * D + colbase;
#pragma unroll
                for (int bj = 0; bj < 2; ++bj) {
                    const f32x4 v0 = acc[ai][bj][m][0], v1 = acc[ai][bj][m][1]; const f32x4 p0 = shfl_xor4(v0, 32), p1 = shfl_xor4(v1, 32);
                    *(u32x4*)(dp + bj * 128) = pk8((v0 * cs0 + p0 * sn0) * sc, (v1 * cs1 + p1 * sn1) * sc);
                }
            }
    }
};
struct EpiVt {
    static constexpr bool PERM = true, AFTER_DRAIN = false;
    bf16_t* VT; const float* ssq;
    __device__ __forceinline__ void operator()(AccRef acc, const pg8::Unit& u, int wr, int wc, int fr, int fq) const {
        const int n0 = u.pm * 256 + wr * 64 + fr, c0 = u.pn * 256; const bool isctx = c0 >= NLAT;
#pragma unroll
        for (int bj = 0; bj < 2; ++bj) {
            const int c = c0 + bj * 128 + wc * 32 + fq * 8;
            int b, kvpos; if (!isctx) { b = c >> 12; kvpos = CTX + (c & 4095); } else { const int cc = c - NLAT; b = cc >> 8; kvpos = cc & 255; }
            f32x4 s0 = {1.f, 1.f, 1.f, 1.f}, s1 = s0;
            if (ssq) { const f32x4 q0 = *(const f32x4*)(ssq + (size_t)c * 2), q1 = *(const f32x4*)(ssq + (size_t)c * 2 + 4), q2 = *(const f32x4*)(ssq + (size_t)c * 2 + 8), q3 = *(const f32x4*)(ssq + (size_t)c * 2 + 12);
                s0[0] = rsqrtf(q0[1] * (1.f / 128.f) + EPS); s0[1] = rsqrtf(q0[3] * (1.f / 128.f) + EPS); s0[2] = rsqrtf(q1[1] * (1.f / 128.f) + EPS); s0[3] = rsqrtf(q1[3] * (1.f / 128.f) + EPS);
                s1[0] = rsqrtf(q2[1] * (1.f / 128.f) + EPS); s1[1] = rsqrtf(q2[3] * (1.f / 128.f) + EPS); s1[2] = rsqrtf(q3[1] * (1.f / 128.f) + EPS); s1[3] = rsqrtf(q3[3] * (1.f / 128.f) + EPS); }
            bf16_t* dp = VT + (size_t)(b * 1024 + n0) * KVLEN + kvpos;
#pragma unroll
            for (int ai = 0; ai < 2; ++ai)
#pragma unroll
                for (int m = 0; m < 4; ++m) *(u32x4*)(dp + (size_t)(ai * 128 + m * 16) * KVLEN) = pk8(acc[ai][bj][m][0] * s0, acc[ai][bj][m][1] * s1);
        }
    }
};
struct EpiMlaDown {
    static constexpr bool PERM = true, AFTER_DRAIN = false;
    bf16_t* CQ; bf16_t* KR; float* ssq; const float* rc; const float* rs;
    __device__ __forceinline__ void operator()(AccRef acc, const pg8::Unit& u, int wr, int wc, int fr, int fq) const {
        const int row0 = u.pm * 256; const bool isctx = row0 >= NLAT; const float sgn = (fq & 1) ? 1.f : -1.f;
#pragma unroll
        for (int ai = 0; ai < 2; ++ai)
#pragma unroll
            for (int m = 0; m < 4; ++m) {
                const int r = row0 + ai * 128 + wr * 64 + m * 16 + fr;
                float sq = dot4(acc[ai][0][m][0]) + dot4(acc[ai][0][m][1]);
                if (u.pn == 0) sq += dot4(acc[ai][1][m][0]) + dot4(acc[ai][1][m][1]);
                sq += __shfl_xor(sq, 16); sq += __shfl_xor(sq, 32);
                if (fq == 0) atomicAdd(ssq + (size_t)r * 2 + (u.pn ? 1 : 0), sq);
                bf16_t* dp = CQ + (size_t)r * 512 + u.pn * 256 + wc * 32 + fq * 8;
                *(u32x4*)(dp) = pk8(acc[ai][0][m][0], acc[ai][0][m][1]);
                if (u.pn == 0) *(u32x4*)(dp + 128) = pk8(acc[ai][1][m][0], acc[ai][1][m][1]);
                else if (wc == 0) {
                    const int s = r & 4095; const int kvr = kvrow_of(r);
                    f32x4 v0 = acc[ai][1][m][0], v1 = acc[ai][1][m][1]; const f32x4 p0 = shfl_xor4(v0, 16), p1 = shfl_xor4(v1, 16);
                    if (!isctx) { const int p = (fq >> 1) ? (s & 63) : (s >> 6);
                        const f32x4 cs0 = *(const f32x4*)(rc + p * 8), cs1 = *(const f32x4*)(rc + p * 8 + 4), sn0 = *(const f32x4*)(rs + p * 8) * sgn, sn1 = *(const f32x4*)(rs + p * 8 + 4) * sgn;
                        v0 = v0 * cs0 + p0 * sn0; v1 = v1 * cs1 + p1 * sn1; }
                    *(u32x4*)(KR + (size_t)kvr * 32 + fq * 8) = pk8(v0, v1);
                }
            }
    }
};
struct EpiMlaQ {
    static constexpr bool PERM = true, AFTER_DRAIN = false;
    bf16_t* QM; const float* ssq; const float* rc; const float* rs; float qscale;
    __device__ __forceinline__ void operator()(AccRef acc, const pg8::Unit& u, int wr, int wc, int fr, int fq) const {
        const int row0 = u.pm * 256; const bool isctx = row0 >= NLAT; const float sgn = (fq & 1) ? 1.f : -1.f;
#pragma unroll
        for (int ai = 0; ai < 2; ++ai)
#pragma unroll
            for (int m = 0; m < 4; ++m) {
                const int r = row0 + ai * 128 + wr * 64 + m * 16 + fr; const int s = r & 4095;
                const float rstd = rsqrtf(ssq[(size_t)r * 2] * (1.f / 256.f) + EPS) * qscale;
                bf16_t* dp = QM + (size_t)r * 1536 + u.pn * 256 + wc * 32 + fq * 8;
#pragma unroll
                for (int bj = 0; bj < 2; ++bj) {
                    const int blk32 = u.pn * 8 + bj * 4 + wc; const bool isrope = (blk32 % 3) == 2;
                    f32x4 v0 = acc[ai][bj][m][0] * rstd, v1 = acc[ai][bj][m][1] * rstd;
                    if (isrope) { const f32x4 p0 = shfl_xor4(v0, 16), p1 = shfl_xor4(v1, 16);
                        if (!isctx) { const int p = (fq >> 1) ? (s & 63) : (s >> 6);
                            const f32x4 cs0 = *(const f32x4*)(rc + p * 8), cs1 = *(const f32x4*)(rc + p * 8 + 4), sn0 = *(const f32x4*)(rs + p * 8) * sgn, sn1 = *(const f32x4*)(rs + p * 8 + 4) * sgn;
                            v0 = v0 * cs0 + p0 * sn0; v1 = v1 * cs1 + p1 * sn1; } }
                    *(u32x4*)(dp + bj * 128) = pk8(v0, v1);
                }
            }
    }
};
struct EpiMlaK {
    static constexpr bool PERM = true, AFTER_DRAIN = false;
    bf16_t* Kb; const float* ssq;
    __device__ __forceinline__ void operator()(AccRef acc, const pg8::Unit& u, int wr, int wc, int fr, int fq) const {
        const int row0 = u.pm * 256;
#pragma unroll
        for (int ai = 0; ai < 2; ++ai)
#pragma unroll
            for (int m = 0; m < 4; ++m) {
                const int r = row0 + ai * 128 + wr * 64 + m * 16 + fr;
                const float rstd = rsqrtf(ssq[(size_t)r * 2 + 1] * (1.f / 128.f) + EPS);
                bf16_t* dp = Kb + (size_t)kvrow_of(r) * D + u.pn * 256 + wc * 32 + fq * 8;
#pragma unroll
                for (int bj = 0; bj < 2; ++bj) *(u32x4*)(dp + bj * 128) = pk8(acc[ai][bj][m][0] * rstd, acc[ai][bj][m][1] * rstd);
            }
    }
};

__device__ __forceinline__ void transpose_item(const float* W, int K, int N, bf16_t* WT, int mode, const float* kscale, LAS float* scr, int item, int lane) {
    const int nblk = N / 32, kb = item / nblk, nb = item % nblk, k0 = 64 * kb, n0 = 32 * nb;
#pragma unroll 8
    for (int i = 0; i < 32; ++i) { const int kk = 2 * i + (lane >> 5); float v = W[(size_t)(k0 + kk) * N + n0 + (lane & 31)]; if (kscale) v *= kscale[k0 + kk]; scr[kk * 33 + (lane & 31)] = v; }
    const int c = lane & 7;
#pragma unroll
    for (int j = 0; j < 4; ++j) { const int n = (lane >> 3) + 8 * j; const LAS float* s = scr + (8 * c) * 33 + n;
        u32x4 o; o.x = pk2(s[0 * 33], s[1 * 33]); o.y = pk2(s[2 * 33], s[3 * 33]); o.z = pk2(s[4 * 33], s[5 * 33]); o.w = pk2(s[6 * 33], s[7 * 33]);
        const int nn = n0 + n; const int drow = (mode == 1) ? ((nn >> 7) * 64 + (nn & 63) + ((nn & 64) ? 1024 : 0)) : nn;
        if (mode == 2) *(u32x4*)(WT + ((size_t)((k0 >> 8) * 1024 + nn)) * 256 + (k0 & 255) + 8 * c) = o;
        else *(u32x4*)(WT + (size_t)drow * K + k0 + 8 * c) = o; }
}

__device__ __forceinline__ void norm_row_compute(const float* xp, const float* g, const float* mp, int shoff, int scoff, int lane, u32x2 (&outv)[4], const float* pp = nullptr, float* wb = nullptr) {
    f32x4 v[4]; float ss = 0.f;
#pragma unroll
    for (int j = 0; j < 4; ++j) { v[j] = *(const f32x4*)(xp + j * 256 + lane * 4);
        if (pp) { const float* q = pp + j * 256 + lane * 4; v[j] = v[j] + ((*(const f32x4*)q + *(const f32x4*)(q + (size_t)NCTX * D)) + (*(const f32x4*)(q + (size_t)2 * NCTX * D) + *(const f32x4*)(q + (size_t)3 * NCTX * D))); *(f32x4*)(wb + j * 256 + lane * 4) = v[j]; }
        ss += dot4(v[j]); }
    ss = wave_sum(ss); const float rstd = rsqrtf(ss * (1.f / 1024.f) + EPS);
#pragma unroll
    for (int j = 0; j < 4; ++j) { const int col = j * 256 + lane * 4;
        const f32x4 gv = *(const f32x4*)(g + col), sc = *(const f32x4*)(mp + scoff + col), sh = *(const f32x4*)(mp + shoff + col);
        outv[j] = pk4(v[j] * rstd * gv * (sc + 1.f) + sh); }
}
__device__ __forceinline__ void norm_rows(const float* xl, const float* xc, int nrows, const float* g, const float* modl, int shoff, int scoff, bf16_t* H, const float* part, float* xcw) {
    const int tid = fresh_tid(), lane = tid & 63, gw = blockIdx.x * NWAVES + __builtin_amdgcn_readfirstlane(tid >> 6), ngw = gridDim.x * NWAVES;
    for (int row_ = gw; row_ < nrows; row_ += ngw) { const int row = nrows - 1 - row_;
        const bool isctx = row >= NLAT; const int bidx = isctx ? BATCH : (row >> 12);
        const float* xp = isctx ? xc + (size_t)(row - NLAT) * D : xl + (size_t)row * D;
        u32x2 o[4];
        if (isctx && part) norm_row_compute(xp, g, modl + bidx * MODROW, shoff, scoff, lane, o, part + (size_t)(row - NLAT) * D, xcw + (size_t)(row - NLAT) * D);
        else norm_row_compute(xp, g, modl + bidx * MODROW, shoff, scoff, lane, o);
#pragma unroll
        for (int j = 0; j < 4; ++j) *(u32x2*)(H + (size_t)row * D + j * 256 + lane * 4) = o[j];
    }
}
__device__ __forceinline__ void norm_rows_T(LAS unsigned char* lds, const float* xl, const float* xc, int nrows, const float* g, const float* modl, int shoff, int scoff, bf16_t* HT, float* hN, float* NYQ) {
    LAS bf16_t* tl = (LAS bf16_t*)lds;
    const int tid = fresh_tid(), lane = tid & 63, wid = __builtin_amdgcn_readfirstlane(tid >> 6);
    const int ntile = BATCH * 64 + (nrows > NLAT ? NCTX / 64 : 0);
    for (int tile_ = blockIdx.x; tile_ < ntile; tile_ += gridDim.x) { const int tile = ntile - 1 - tile_;
        const bool isctx = tile >= BATCH * 64;
        const int b = isctx ? ((tile - BATCH * 64) >> 2) : (tile >> 6);
        const int s0 = isctx ? ((tile - BATCH * 64) & 3) * 64 : (tile & 63) * 32;
        const int bidx = isctx ? BATCH : b;
        for (int i = 0; i < 8; ++i) { const int slot = wid * 8 + i;
            const float* xp;
            if (isctx) xp = xc + (size_t)(b * CTX + s0 + slot) * D;
            else { int tok = slot < 32 ? s0 + slot : SEQ - (s0 + slot - 32); if (s0 == 0 && slot == 32) tok = SEQ / 2; xp = xl + (size_t)(b * SEQ + tok) * D; }
            u32x2 o[4]; norm_row_compute(xp, g, modl + bidx * MODROW, shoff, scoff, lane, o);
#pragma unroll
            for (int j = 0; j < 4; ++j) *(LAS u32x2*)(tl + slot * 1028 + j * 256 + lane * 4) = o[j]; }
        __syncthreads();
        if (isctx) {
            bf16_t* dst = HT + (size_t)NLAT * D + (size_t)b * D * CTX;
            for (int k = 0; k < 16; ++k) { const int it = tid + 512 * k, d = it >> 3, c = it & 7;
                const LAS bf16_t* sp = tl + (8 * c) * 1028 + d;
                u32x4 w; w.x = (unsigned)sp[0] | ((unsigned)sp[1028] << 16); w.y = (unsigned)sp[2 * 1028] | ((unsigned)sp[3 * 1028] << 16);
                w.z = (unsigned)sp[4 * 1028] | ((unsigned)sp[5 * 1028] << 16); w.w = (unsigned)sp[6 * 1028] | ((unsigned)sp[7 * 1028] << 16);
                *(u32x4*)(dst + (size_t)d * CTX + s0 + 8 * c) = w; }
        } else {
            bf16_t* he_dst = HT + (size_t)b * D * 2048; bf16_t* ho_dst = HT + (size_t)BATCH * D * 2048 + (size_t)b * D * 2048;
            for (int k = 0; k < 8; ++k) { const int it = tid + 512 * k, d = it >> 2, c = it & 3;
                const LAS bf16_t* sp = tl + (8 * c) * 1028 + d;
                float he[8], ho[8]; float nq = 0.f;
#pragma unroll
                for (int j = 0; j < 8; ++j) { const float lo = __uint_as_float((unsigned)sp[j * 1028] << 16), hi = __uint_as_float((unsigned)sp[(32 + j) * 1028] << 16);
                    he[j] = lo + hi; ho[j] = lo - hi;
                    if (j == 0 && c == 0 && s0 == 0) { he[0] = lo; ho[0] = 0.f; hN[b * D + d] = hi; }
                    nq += (j & 1) ? -he[j] : he[j]; }
                u32x4 we, wo; we.x = pk2(he[0], he[1]); we.y = pk2(he[2], he[3]); we.z = pk2(he[4], he[5]); we.w = pk2(he[6], he[7]);
                wo.x = pk2(ho[0], ho[1]); wo.y = pk2(ho[2], ho[3]); wo.z = pk2(ho[4], ho[5]); wo.w = pk2(ho[6], ho[7]);
                *(u32x4*)(he_dst + (size_t)d * 2048 + s0 + 8 * c) = we; *(u32x4*)(ho_dst + (size_t)d * 2048 + s0 + 8 * c) = wo;
                nq += __shfl_xor(nq, 1); nq += __shfl_xor(nq, 2);
                if (c == 0) atomicAdd(NYQ + b * D + d, nq); }
        }
        __syncthreads();
    }
}

__device__ __forceinline__ int crow(int r, int hi) { return (r & 3) + 8 * (r >> 2) + 4 * hi; }
#define MFMA32(a, b, c) __builtin_amdgcn_mfma_f32_32x32x16_bf16((a), (b), (c), 0, 0, 0)
template <int BASE> __device__ __forceinline__ bf16x8 pack8(const f32x16& p) {
    u32x4 w; w.x = pk2(p[BASE], p[BASE + 1]); w.y = pk2(p[BASE + 2], p[BASE + 3]); w.z = pk2(p[BASE + 4], p[BASE + 5]); w.w = pk2(p[BASE + 6], p[BASE + 7]); return __builtin_bit_cast(bf16x8, w);
}
constexpr float ATT_THR = 8.f;
#define SGB(mask, n) __builtin_amdgcn_sched_group_barrier((mask), (n), 0)
#define SBAR0() __builtin_amdgcn_sched_barrier(0)
template <int NKD, int KSTRIDE> __device__ __forceinline__ void att_qk(const LAS unsigned char* kb, const bf16x8 (&qr)[NKD], f32x16& c0, f32x16& c1) {
    f32x16 z;
#pragma unroll
    for (int r = 0; r < 16; ++r) z[r] = 0.f;
#pragma unroll
    for (int d0 = 0; d0 < NKD; ++d0) { const bf16x8 k0 = *(const LAS bf16x8*)(kb + d0 * 32), k1 = *(const LAS bf16x8*)(kb + 32 * KSTRIDE + d0 * 32);
        c0 = MFMA32(k0, qr[d0], d0 == 0 ? z : c0); c1 = MFMA32(k1, qr[d0], d0 == 0 ? z : c1); }
}
template <int VSTRIDE> __device__ __forceinline__ void att_vpre(const LAS unsigned char* vb, bf16x8 (&vf)[8]) {
#pragma unroll
    for (int i = 0; i < 8; ++i) vf[i] = *(const volatile LAS bf16x8*)(vb + (i >> 2) * 32 * VSTRIDE + (i & 3) * 32);
}
template <int NKD, int KSTRIDE> __device__ __forceinline__ void att_kread(const LAS unsigned char* kb, bf16x8 (&kf)[2 * NKD]) {
#pragma unroll
    for (int d0 = 0; d0 < NKD; ++d0) { kf[2 * d0] = *(const volatile LAS bf16x8*)(kb + d0 * 32); kf[2 * d0 + 1] = *(const volatile LAS bf16x8*)(kb + 32 * KSTRIDE + d0 * 32); }
}
template <int NKD, int KSTRIDE, int VSTRIDE> __device__ __forceinline__ void att_regionA(const bf16x8 (&kf)[2 * NKD], const bf16x8 (&qr)[NKD], f32x16& c0, f32x16& c1,
                                                                            const f32x16& pp0, const f32x16& pp1, float& lrun, bf16x8 (&pf)[4], const LAS unsigned char* vb, bf16x8 (&vf)[8]) {
    SBAR0();
    __builtin_amdgcn_s_setprio(1);
    f32x16 z;
#pragma unroll
    for (int r = 0; r < 16; ++r) z[r] = 0.f;
#pragma unroll
    for (int d0 = 0; d0 < NKD; ++d0) { c0 = MFMA32(kf[2 * d0], qr[d0], d0 == 0 ? z : c0); c1 = MFMA32(kf[2 * d0 + 1], qr[d0], d0 == 0 ? z : c1); }
    float s0 = 0.f, s1 = 0.f;
#pragma unroll
    for (int r = 0; r < 16; ++r) { s0 += pp0[r]; s1 += pp1[r]; }
    pf[0] = pack8<0>(pp0); pf[1] = pack8<8>(pp0); pf[2] = pack8<0>(pp1); pf[3] = pack8<8>(pp1);
    lrun += s0 + s1;
    att_vpre<VSTRIDE>(vb, vf);
    asm volatile("" : "+v"(lrun), "+v"(pf[0]), "+v"(pf[1]), "+v"(pf[2]), "+v"(pf[3]));
    SGB(0x008, NKD / 2);
#pragma unroll
    for (int i = 0; i < 2 * NKD - NKD / 2; ++i) { SGB(0x008, 1); SGB(0x002, 48 / (2 * NKD - NKD / 2)); }
    SGB(0x100, 8);
    __builtin_amdgcn_s_setprio(0);
    SBAR0();
}
__device__ __forceinline__ bool att_decide(f32x16& c0, f32x16& c1, float& mhat, float& lrun, float& fsc) {
    c0 = c0 - mhat; c1 = c1 - mhat;
    float ra = fmaxf(fmaxf(c0[0], c0[1]), c0[2]), rb = fmaxf(fmaxf(c1[0], c1[1]), c1[2]);
#pragma unroll
    for (int r = 3; r < 15; r += 2) { ra = fmaxf(fmaxf(ra, c0[r]), c0[r + 1]); rb = fmaxf(fmaxf(rb, c1[r]), c1[r + 1]); }
    float rm = fmaxf(fmaxf(ra, rb), fmaxf(c0[15], c1[15]));
    { auto rr = __builtin_amdgcn_permlane32_swap(__float_as_uint(rm), __float_as_uint(rm), false, false); rm = fmaxf(__uint_as_float(rr[0]), __uint_as_float(rr[1])); }
    bool resc = false; fsc = 1.f;
    if (__builtin_expect(__any(rm > ATT_THR), 0)) { asm volatile("; rare: reference update" ::: "memory"); const float dl = fmaxf(rm, 0.f); mhat += dl; fsc = __builtin_amdgcn_exp2f(-dl); lrun *= fsc; c0 = c0 - dl; c1 = c1 - dl; resc = true; }
    return resc;
}
template <int NBLK, int VSTRIDE> __device__ __forceinline__ void att_regionB(const LAS unsigned char* vb, const bf16x8 (&pf)[4], f32x16 (&o)[NBLK], f32x16& c0, f32x16& c1, const bf16x8 (&vf)[8], bool doexp) {
    SBAR0();
    __builtin_amdgcn_s_setprio(1);
    bf16x8 vg[8];
    if (NBLK == 4) {
#pragma unroll
        for (int i = 0; i < 8; ++i) vg[i] = *(const LAS bf16x8*)(vb + (2 + (i >> 2)) * 32 * VSTRIDE + (i & 3) * 32);
    }
#pragma unroll
    for (int i = 0; i < 8; ++i) o[i >> 2] = MFMA32(pf[i & 3], vf[i], o[i >> 2]);
    if (NBLK == 4) {
#pragma unroll
        for (int i = 0; i < 8; ++i) o[(NBLK == 4 ? 2 : 0) + (i >> 2)] = MFMA32(pf[i & 3], vg[i], o[(NBLK == 4 ? 2 : 0) + (i >> 2)]);
    }
    if (doexp) {
#pragma unroll
        for (int r = 0; r < 16; ++r) { c0[r] = __builtin_amdgcn_exp2f(c0[r]); c1[r] = __builtin_amdgcn_exp2f(c1[r]); }
        asm volatile("" : "+v"(c0), "+v"(c1));
        if (NBLK == 4) {
#pragma unroll
            for (int i = 0; i < 8; ++i) { SGB(0x008, 1); SGB(0x400, 2); SGB(0x100, 1); }
#pragma unroll
            for (int i = 0; i < 8; ++i) { SGB(0x008, 1); SGB(0x400, 2); }
        } else {
#pragma unroll
            for (int i = 0; i < 8; ++i) { SGB(0x008, 1); SGB(0x400, 4); }
        }
    }
    __builtin_amdgcn_s_setprio(0);
    SBAR0();
}
template <int NBLK> __device__ __forceinline__ void att_rescale(f32x16 (&o)[NBLK], float fsc, int hi) {
#pragma unroll
    for (int r = 0; r < 16; ++r) { const float fr_ = __shfl(fsc, crow(r, hi));
#pragma unroll
        for (int k = 0; k < NBLK; ++k) o[k][r] *= fr_; }
}
__device__ __forceinline__ void att_first(f32x16& c0, f32x16& c1, float& mhat) {
    float rm = fmaxf(c0[0], c1[0]);
#pragma unroll
    for (int r = 1; r < 16; ++r) rm = fmaxf(rm, fmaxf(c0[r], c1[r]));
    rm = fmaxf(rm, __shfl_xor(rm, 32)); mhat = rm;
#pragma unroll
    for (int r = 0; r < 16; ++r) { c0[r] = __builtin_amdgcn_exp2f(c0[r] - mhat); c1[r] = __builtin_amdgcn_exp2f(c1[r] - mhat); }
}

__device__ __forceinline__ void glds16(const void* gsrc, unsigned lds_dst) { unsigned keep;
    asm volatile("s_mov_b32 %0, m0\n\ts_mov_b32 m0, %2\n\ts_nop 0\n\tglobal_load_lds_dwordx4 %1, off\n\ts_mov_b32 m0, %0" : "=&s"(keep) : "v"(gsrc), "s"(lds_dst) : "memory"); }
#define WAIT_BAR(N) asm volatile("s_waitcnt vmcnt(" #N ") lgkmcnt(0)\n\ts_barrier" ::: "memory")
__device__ __forceinline__ int pi_row(int i) { return (i & ~12) | ((i & 4) << 1) | ((i & 8) >> 1); }

constexpr int DK_STRIDE = 272, DV_STRIDE = 144, D_KB = 64 * DK_STRIDE, D_VB = 128 * DV_STRIDE, D_VRING = 3 * D_KB;
__device__ __forceinline__ void attn_diff_unit(LAS unsigned char* lds, const bf16_t* __restrict__ Q, const bf16_t* __restrict__ Kb, const bf16_t* __restrict__ VT, bf16_t* O,
                                               int qrow0, int b, int h, int ntiles, float lam, const float* subln_g) {
    int tid_l = threadIdx.x; asm volatile("" : "+v"(tid_l)); const int tid = tid_l, lane = tid & 63, r32 = lane & 31, hi = lane >> 5;
    const int wid = __builtin_amdgcn_readfirstlane(tid >> 6), sub = wid >> 2, wq = wid & 3;
    const unsigned lds0 = (unsigned)(size_t)lds;
    bf16x8 qr[4];
    { const bf16_t* qp = Q + (size_t)(qrow0 + 32 * wq + r32) * D + h * 128 + sub * 64 + hi * 8;
#pragma unroll
      for (int d0 = 0; d0 < 4; ++d0) qr[d0] = *(const bf16x8*)(qp + d0 * 16); }
    asm volatile("s_waitcnt vmcnt(0)" ::: "memory");
    const bf16_t* kbase = Kb + (size_t)b * KVLEN * D + h * 128; const bf16_t* vbase = VT + (size_t)(b * 1024 + h * 128) * KVLEN;
    int poff[5], pdst[5]; const bool w0 = (wid == 0);
#pragma unroll
    for (int j = 0; j < 5; ++j) { int P = wid + 8 * j; if (P >= 35) P -= 8;
        const bool isk = (j < 2) || (j == 2 && w0);
        const int pk = isk ? P : P - 17, g = pk * 64 + lane;
        const int ik = g / 17, cik = g - ik * 17, iv = g / 9, civ = g - iv * 9;
        poff[j] = isk ? pi_row(ik) * D + (cik > 15 ? 15 : cik) * 8 : iv * KVLEN + (civ > 7 ? 7 : civ) * 8; pdst[j] = pk * 1024; }
    int ks3 = 0, vs4 = 0;
    int tiss = 0;
#define D_ISSUE_A() do { const bf16_t* kb_ = kbase + (size_t)tiss * 65536; const unsigned kd_ = lds0 + ks3 * D_KB; \
        glds16(kb_ + poff[0], (unsigned)__builtin_amdgcn_readfirstlane(kd_ + pdst[0])); glds16(kb_ + poff[1], (unsigned)__builtin_amdgcn_readfirstlane(kd_ + pdst[1])); } while (0)
#define D_ISSUE_B() do { const bf16_t* kb_ = kbase + (size_t)tiss * 65536; const bf16_t* vb_ = vbase + (size_t)tiss * 64; \
        const unsigned kd_ = lds0 + ks3 * D_KB, vd_ = lds0 + D_VRING + vs4 * D_VB; \
        glds16((w0 ? kb_ : vb_) + poff[2], (unsigned)__builtin_amdgcn_readfirstlane((w0 ? kd_ : vd_) + pdst[2])); \
        glds16(vb_ + poff[3], (unsigned)__builtin_amdgcn_readfirstlane(vd_ + pdst[3])); glds16(vb_ + poff[4], (unsigned)__builtin_amdgcn_readfirstlane(vd_ + pdst[4])); \
        ++tiss; ks3 = (ks3 == 2) ? 0 : ks3 + 1; vs4 = (vs4 + 1) & 3; } while (0)
#define D_ISSUE() do { D_ISSUE_A(); D_ISSUE_B(); } while (0)
    const int koff = r32 * DK_STRIDE + (sub * 64 + hi * 8) * 2;
    const int voff = D_VRING + r32 * DV_STRIDE + hi * 16;
    D_ISSUE(); D_ISSUE();
    f32x16 o[4];
#pragma unroll
    for (int k = 0; k < 4; ++k)
#pragma unroll
        for (int r = 0; r < 16; ++r) o[k][r] = 0.f;
    float mhat = 0.f, lrun = 0.f, fsc = 1.f;
    f32x16 pA0, pA1, pB0, pB1; bf16x8 pf[4], vf[8];
    WAIT_BAR(5);
    D_ISSUE();
    att_qk<4, DK_STRIDE>(lds + koff, qr, pA0, pA1);
    att_first(pA0, pA1, mhat);
    WAIT_BAR(5);
    int kc = 1, vc = 0;
#define D_STEP(C0, C1, P0, P1) do { \
        bf16x8 kf_[8]; att_kread<4, DK_STRIDE>(lds + kc * D_KB + koff, kf_); \
        if (sub == 0) D_ISSUE_A(); \
        att_regionA<4, DK_STRIDE, DV_STRIDE>(kf_, qr, C0, C1, P0, P1, lrun, pf, lds + vc * D_VB + voff, vf); \
        if (sub != 0) D_ISSUE_A(); \
        const bool resc_ = att_decide(C0, C1, mhat, lrun, fsc); \
        if (sub == 0) D_ISSUE_B(); \
        att_regionB<4, DV_STRIDE>(lds + vc * D_VB + voff, pf, o, C0, C1, vf, true); \
        if (sub != 0) D_ISSUE_B(); \
        if (__builtin_expect(resc_, 0)) { asm volatile("; rare: rescale O" ::: "memory"); att_rescale<4>(o, fsc, hi); } \
        kc = (kc == 2) ? 0 : kc + 1; vc = (vc + 1) & 3; \
        WAIT_BAR(5); } while (0)
    int t = 1;
    for (; t + 1 < ntiles; t += 2) { D_STEP(pB0, pB1, pA0, pA1); D_STEP(pA0, pA1, pB0, pB1); }
    D_STEP(pB0, pB1, pA0, pA1);
    { float s = 0.f;
#pragma unroll
      for (int r = 0; r < 16; ++r) s += pB0[r] + pB1[r];
      lrun += s; pf[0] = pack8<0>(pB0); pf[1] = pack8<8>(pB0); pf[2] = pack8<0>(pB1); pf[3] = pack8<8>(pB1);
      att_vpre<DV_STRIDE>(lds + vc * D_VB + voff, vf); att_regionB<4, DV_STRIDE>(lds + vc * D_VB + voff, pf, o, pA0, pA1, vf, false); }
    WAIT_BAR(0);
#undef D_ISSUE
#undef D_ISSUE_A
#undef D_ISSUE_B
#undef D_STEP
    asm volatile("" : "+s"(qrow0), "+s"(h));
    { const float ltot = lrun + __shfl_xor(lrun, 32); const float inv = 1.f / ltot;
#pragma unroll
      for (int r = 0; r < 16; ++r) { const float ri = __shfl(inv, crow(r, hi));
#pragma unroll
          for (int k = 0; k < 4; ++k) o[k][r] *= ri; } }
    LAS float* ex = (LAS float*)lds;
    if (sub == 1) {
#pragma unroll
        for (int k = 0; k < 4; ++k)
#pragma unroll
            for (int r = 0; r < 16; ++r) ex[(wq * 64 + k * 16 + r) * 64 + lane] = o[k][r];
    }
    __syncthreads();
    if (sub == 0) {
        float ssq[16];
#pragma unroll
        for (int r = 0; r < 16; ++r) { float s = 0.f;
#pragma unroll
            for (int k = 0; k < 4; ++k) { const float d = o[k][r] - lam * ex[(wq * 64 + k * 16 + r) * 64 + lane]; o[k][r] = d; s += d * d; }
            s += __shfl_xor(s, 1); s += __shfl_xor(s, 2); s += __shfl_xor(s, 4); s += __shfl_xor(s, 8); s += __shfl_xor(s, 16);
            ssq[r] = rsqrtf(s * (1.f / 128.f) + EPS); }
#pragma unroll
        for (int k = 0; k < 4; ++k) { const float g = subln_g[k * 32 + r32] * (1.f - LAM_INIT);
#pragma unroll
            for (int r = 0; r < 16; ++r) O[(size_t)(qrow0 + 32 * wq + crow(r, hi)) * D + h * 128 + k * 32 + r32] = f2bf(o[k][r] * ssq[r] * g); }
    }
    asm volatile("s_waitcnt vmcnt(0)" ::: "memory");
    __syncthreads();
}

constexpr int MK_STRIDE = 208, MV_STRIDE = 144, M_KB = 64 * MK_STRIDE, M_VB = 64 * MV_STRIDE, M_VRING = 3 * M_KB;
__device__ __forceinline__ void attn_mla_unit(LAS unsigned char* lds, const bf16_t* __restrict__ QM, const bf16_t* __restrict__ Kb, const bf16_t* __restrict__ KR, const bf16_t* __restrict__ VT, bf16_t* O,
                                              int qrow0, int b, int h, int ntiles) {
    int tid_l = threadIdx.x; asm volatile("" : "+v"(tid_l)); const int tid = tid_l, lane = tid & 63, r32 = lane & 31, hi = lane >> 5;
    const int wid = __builtin_amdgcn_readfirstlane(tid >> 6);
    const unsigned lds0 = (unsigned)(size_t)lds;
    bf16x8 qr[6];
    { const bf16_t* qp = QM + (size_t)(qrow0 + 32 * wid + r32) * 1536 + h * 96 + hi * 8;
#pragma unroll
      for (int d0 = 0; d0 < 6; ++d0) qr[d0] = *(const bf16x8*)(qp + d0 * 16); }
    asm volatile("s_waitcnt vmcnt(0)" ::: "memory");
    const bf16_t* kbase = Kb + (size_t)b * KVLEN * D + h * 64; const bf16_t* rbase = KR + (size_t)b * KVLEN * 32; const bf16_t* vbase = VT + (size_t)(b * 1024 + h * 64) * KVLEN;
    int poff[3], pdst[3], pstep[3]; bool pisk[3], pisr[3];
#pragma unroll
    for (int j = 0; j < 3; ++j) { int P = wid + 8 * j; if (P >= 22) P -= 8;
        if (P < 13) { const int g = P * 64 + lane, i = g / 13; int cin = g - i * 13; cin = cin > 11 ? 11 : cin; const int key = pi_row(i);
            pisr[j] = cin >= 8; poff[j] = pisr[j] ? key * 32 + (cin - 8) * 8 : key * D + cin * 8; pstep[j] = pisr[j] ? 2048 : 65536; pdst[j] = P * 1024; pisk[j] = true; }
        else { const int p = P - 13, g = p * 64 + lane, dv = g / 9; int cin = g - dv * 9; cin = cin > 7 ? 7 : cin; poff[j] = dv * KVLEN + cin * 8; pstep[j] = 64; pdst[j] = p * 1024; pisk[j] = false; pisr[j] = false; } }
    int ks3 = 0, vs4 = 0, tiss = 0;
#define M_ISSUE() do { const unsigned kd_ = lds0 + ks3 * M_KB, vd_ = lds0 + M_VRING + vs4 * M_VB; \
        _Pragma("unroll") for (int j = 0; j < 3; ++j) { \
            if (pisk[j]) { const bf16_t* src_ = (pisr[j] ? rbase : kbase) + (size_t)(poff[j] + tiss * pstep[j]); glds16(src_, (unsigned)__builtin_amdgcn_readfirstlane(kd_ + pdst[j])); } \
            else glds16(vbase + (size_t)(poff[j] + tiss * 64), (unsigned)__builtin_amdgcn_readfirstlane(vd_ + pdst[j])); } \
        ++tiss; ks3 = (ks3 == 2) ? 0 : ks3 + 1; vs4 = (vs4 + 1) & 3; } while (0)
    const int koff = r32 * MK_STRIDE + hi * 16;
    const int voff = M_VRING + r32 * MV_STRIDE + hi * 16;
    M_ISSUE(); M_ISSUE();
    f32x16 o[2];
#pragma unroll
    for (int k = 0; k < 2; ++k)
#pragma unroll
        for (int r = 0; r < 16; ++r) o[k][r] = 0.f;
    float mhat = 0.f, lrun = 0.f, fsc = 1.f;
    f32x16 pA0, pA1, pB0, pB1; bf16x8 pf[4], vf[8];
    WAIT_BAR(3);
    M_ISSUE();
    att_qk<6, MK_STRIDE>(lds + koff, qr, pA0, pA1);
    att_first(pA0, pA1, mhat);
    WAIT_BAR(3);
    int kc = 1, vc = 0;
#define M_STEP(C0, C1, P0, P1) do { \
        bf16x8 kf_[12]; att_kread<6, MK_STRIDE>(lds + kc * M_KB + koff, kf_); \
        if (wid < 4) M_ISSUE(); \
        att_regionA<6, MK_STRIDE, MV_STRIDE>(kf_, qr, C0, C1, P0, P1, lrun, pf, lds + vc * M_VB + voff, vf); \
        if (wid >= 4) M_ISSUE(); \
        const bool resc_ = att_decide(C0, C1, mhat, lrun, fsc); \
        att_regionB<2, MV_STRIDE>(lds + vc * M_VB + voff, pf, o, C0, C1, vf, true); \
        if (__builtin_expect(resc_, 0)) { asm volatile("; rare: rescale O" ::: "memory"); att_rescale<2>(o, fsc, hi); } \
        kc = (kc == 2) ? 0 : kc + 1; vc = (vc + 1) & 3; \
        WAIT_BAR(3); } while (0)
    int t = 1;
    for (; t + 1 < ntiles; t += 2) { M_STEP(pB0, pB1, pA0, pA1); M_STEP(pA0, pA1, pB0, pB1); }
    M_STEP(pB0, pB1, pA0, pA1);
    { float s = 0.f;
#pragma unroll
      for (int r = 0; r < 16; ++r) s += pB0[r] + pB1[r];
      lrun += s; pf[0] = pack8<0>(pB0); pf[1] = pack8<8>(pB0); pf[2] = pack8<0>(pB1); pf[3] = pack8<8>(pB1);
      att_vpre<MV_STRIDE>(lds + vc * M_VB + voff, vf); att_regionB<2, MV_STRIDE>(lds + vc * M_VB + voff, pf, o, pA0, pA1, vf, false); }
    WAIT_BAR(0);
#undef M_ISSUE
#undef M_STEP
    asm volatile("" : "+s"(qrow0), "+s"(h));
    const float ltot = lrun + __shfl_xor(lrun, 32); const float inv = 1.f / ltot;
#pragma unroll
    for (int r = 0; r < 16; ++r) { const float ri = __shfl(inv, crow(r, hi));
#pragma unroll
        for (int k = 0; k < 2; ++k) O[(size_t)(qrow0 + 32 * wid + crow(r, hi)) * D + h * 64 + k * 32 + r32] = f2bf(o[k][r] * ri); }
    asm volatile("s_waitcnt vmcnt(0)" ::: "memory");
}

#define XB_TMO      128
#define XB_XCNT(j)  (256  + 64 * (j))
#define XB_XSUB(j)  (1280 + 64 * (j))
#define XB_XGEN(j)  (2304 + 64 * (j))
#define XB_TOP      3328
#define XB_TOPGEN   3392
#define XCD_BAR_WORDS 3456
#define XB_SPIN_CAP (1u << 18)

__device__ __forceinline__ unsigned xb_ld(unsigned* p)              { return __hip_atomic_load(p, __ATOMIC_RELAXED, __HIP_MEMORY_SCOPE_AGENT); }
__device__ __forceinline__ unsigned xb_add(unsigned* p, unsigned v) { return __hip_atomic_fetch_add(p, v, __ATOMIC_RELAXED, __HIP_MEMORY_SCOPE_AGENT); }
__device__ __forceinline__ unsigned xb_xcc_id() { return (unsigned)__builtin_amdgcn_s_getreg((3 << 11) | 20) & 0xFu; }
#define XB_SPIN(cond, bar) do { unsigned _sp = 0; while (cond) { __builtin_amdgcn_s_sleep(1); \
    if ((++_sp & 255u) == 0u) { if (xb_ld(&(bar)[XB_TMO])) break; if (_sp > XB_SPIN_CAP) { atomicAdd(&(bar)[XB_TMO], 1u); break; } } } } while (0)

struct XcdBarrier {
    unsigned* bar; unsigned x;
    volatile LAS unsigned* st;
};

__device__ __forceinline__ XcdBarrier xcd_barrier_post(unsigned* bar, volatile LAS unsigned* st) {
    XcdBarrier b; b.bar = bar; b.x = xb_xcc_id(); b.st = st;
    if (threadIdx.x == 0) (void)xb_add(&bar[XB_XCNT(b.x)], 1u);
    return b;
}
__device__ __forceinline__ void xcd_barrier_complete(unsigned* bar, unsigned x, unsigned& nloc, unsigned& nx) {
    const unsigned G = gridDim.x * gridDim.y * gridDim.z;
    unsigned sum, cnt, mine, sp = 0u;
    for (;;) {
        sum = 0u; cnt = 0u; mine = 0u;
#pragma unroll
        for (unsigned j = 0; j < 16; ++j) { const unsigned c = xb_ld(&bar[XB_XCNT(j)]); sum += c; cnt += (c > 0u) ? 1u : 0u; mine = (j == x) ? c : mine; }
        if (sum == G) break;
        __builtin_amdgcn_s_sleep(1);
        if ((++sp & 255u) == 0u) { if (xb_ld(&bar[XB_TMO])) break; if (sp > XB_SPIN_CAP) { atomicAdd(&bar[XB_TMO], 1u); break; } }
    }
    nloc = mine > 0u ? mine : 1u; nx = cnt > 0u ? cnt : 1u;
}

__device__ __forceinline__ void xcd_barrier(const XcdBarrier& b) {
    asm volatile("s_waitcnt vmcnt(0)" ::: "memory");
    __syncthreads();
    if (threadIdx.x == 0) {
        unsigned* bar = b.bar;
        __builtin_amdgcn_s_waitcnt(0);
        unsigned nloc = b.st[0], nx = b.st[1];
        if (nloc == 0u) { xcd_barrier_complete(bar, b.x, nloc, nx); b.st[0] = nloc; b.st[1] = nx; }
        const unsigned old = xb_add(&bar[XB_XSUB(b.x)], 1u);
        const unsigned gen = old / nloc;
        if (old + 1u == (gen + 1u) * nloc) {
            __builtin_amdgcn_fence(__ATOMIC_RELEASE, "agent");
            asm volatile("s_waitcnt vmcnt(0)" ::: "memory");
            const unsigned og = xb_add(&bar[XB_TOP], 1u);
            const unsigned tg = og / nx;
            if (og + 1u == (tg + 1u) * nx) xb_add(&bar[XB_TOPGEN], 1u);
            else XB_SPIN(xb_ld(&bar[XB_TOPGEN]) == tg, bar);
            __builtin_amdgcn_fence(__ATOMIC_ACQUIRE, "agent");
            xb_add(&bar[XB_XGEN(b.x)], 1u);
            asm volatile("s_waitcnt vmcnt(0)" ::: "memory");
        } else {
            XB_SPIN(xb_ld(&bar[XB_XGEN(b.x)]) == gen, bar);
            __builtin_amdgcn_fence(__ATOMIC_ACQUIRE, "agent");
            asm volatile("s_waitcnt vmcnt(0)" ::: "memory");
        }
    }
    __syncthreads();
}

struct Args { const float* in[26]; float* out; unsigned char* ws; };

#define GEMM_CALL(EPI, gA, gB, gM, gN, gK, gLDA, gLDB, cshift, Eobj) do { \
        pg8::Gemm gg__{(gA), (gB), (gM), (gN), (gK), (gLDA), (gLDB)}; pg8::StaticOrder so__; so__.init((gM), (gN), G, (int)((blockIdx.x + G - ((cshift) % G)) % G)); \
        pg8::gemm_phase<EPI, pg8::StaticOrder, true, true>(lds, gg__, so__, (Eobj)); } while (0)

__global__ void __launch_bounds__(512, 2) fwd_megakernel(Args a) {
    extern __shared__ __attribute__((aligned(16))) unsigned char lds_raw[];
    LAS unsigned char* lds = (LAS unsigned char*)lds_raw;
    const int G = gridDim.x;
    unsigned char* ws = a.ws;
    const float* x_in = a.in[0]; const float* c_in = a.in[1]; const float* ctx_in = a.in[2]; const float* cctx_in = a.in[3];
    const float* mod_w = a.in[4]; const float* mod_b = a.in[5]; const float* norm_mix_g = a.in[6]; const float* norm_mlp_g = a.in[7]; const float* final_g = a.in[8];
    float* out = a.out;
    float* MOD = (float*)(ws + WS_MOD);
    float* ropeDc = (float*)(ws + WS_ROPE); float* ropeDs = ropeDc + 1024; float* ropeMc = ropeDc + 2048; float* ropeMs = ropeDc + 2560; float* lamp = ropeDc + 3072;
    float* SSQ = (float*)(ws + WS_SSQ);
    unsigned* BARW = (unsigned*)(ws + WS_ROPE + 65536); float* NYQ = (float*)(ws + WS_ROPE + 131072); float* HN = (float*)(ws + WS_ROPE + 196608);
    bf16_t* W1T = (bf16_t*)(ws + WS_W1T); bf16_t* W2T = (bf16_t*)(ws + WS_W2T); bf16_t* DQKV = (bf16_t*)(ws + WS_DQKV); bf16_t* DWO = (bf16_t*)(ws + WS_DWO);
    bf16_t* MDOWN = (bf16_t*)(ws + WS_MDOWN); bf16_t* MUQ = (bf16_t*)(ws + WS_MUQ); bf16_t* MUKV = (bf16_t*)(ws + WS_MUKV); bf16_t* MWO = (bf16_t*)(ws + WS_MWO);
    bf16_t* FWT = (bf16_t*)(ws + WS_FWT); bf16_t* FMW = (bf16_t*)(ws + WS_FMW); bf16_t* DFT256 = (bf16_t*)(ws + WS_DFT256); bf16_t* DFT4K = (bf16_t*)(ws + WS_DFT4K);
    float* XC = (float*)(ws + WS_XC); bf16_t* H = (bf16_t*)(ws + WS_H); bf16_t* CQ = (bf16_t*)(ws + WS_CQ); bf16_t* KR = (bf16_t*)(ws + WS_KR);
    bf16_t* BIG = (bf16_t*)(ws + WS_BIG); float* PART = (float*)(ws + WS_PART);

    {
        const int tid = fresh_tid(), lane = tid & 63, wid = __builtin_amdgcn_readfirstlane(tid >> 6);
        const int gw = blockIdx.x * NWAVES + wid, ngw = G * NWAVES;
        const size_t gtid = (size_t)blockIdx.x * 512 + tid, gthreads = (size_t)G * 512;
        if (blockIdx.x == 0) for (int i = tid; i < XCD_BAR_WORDS; i += 512) BARW[i] = 0u;
        if (tid < 4) ((volatile LAS unsigned*)(lds + LDS_BYTES - 16))[tid] = 0u;
        LAS float* s_silu = (LAS float*)lds;
        LAS float* red = (LAS float*)(lds + NB * 1024 * 4);
        if ((int)blockIdx.x < DEPTH * 96) {
            for (int i = tid; i < NB * 1024; i += 512) { const float v = (i < BATCH * 1024) ? c_in[i] : cctx_in[i - BATCH * 1024]; s_silu[i] = v / (1.f + __expf(-v)); }
            __syncthreads();
            for (int item = blockIdx.x; item < DEPTH * 96; item += G) {
                const int l = item / 96, chunk = item % 96, n = chunk * 64 + lane;
                float acc[NB];
#pragma unroll
                for (int j = 0; j < NB; ++j) acc[j] = 0.f;
                const float* wp = mod_w + ((size_t)l * 1024 + 128 * wid) * MODROW + n;
                for (int k4 = 0; k4 < 32; ++k4) {
                    const float w0 = wp[(size_t)(4 * k4 + 0) * MODROW], w1 = wp[(size_t)(4 * k4 + 1) * MODROW], w2 = wp[(size_t)(4 * k4 + 2) * MODROW], w3 = wp[(size_t)(4 * k4 + 3) * MODROW];
#pragma unroll
                    for (int j = 0; j < NB; ++j) { const f32x4 s = *(const LAS f32x4*)(s_silu + j * 1024 + 128 * wid + 4 * k4); acc[j] += (s[0] * w0 + s[1] * w1) + (s[2] * w2 + s[3] * w3); }
                }
#pragma unroll
                for (int j = 0; j < NB; ++j) red[(wid * NB + j) * 64 + lane] = acc[j];
                __syncthreads();
                for (int idx = tid; idx < NB * 64; idx += 512) { const int j = idx >> 6, ln = idx & 63; float s = 0.f;
#pragma unroll
                    for (int w = 0; w < 8; ++w) s += red[(w * NB + j) * 64 + ln];
                    MOD[((size_t)l * NB + j) * MODROW + chunk * 64 + ln] = s + mod_b[l * MODROW + chunk * 64 + ln]; }
                __syncthreads();
            }
        }
        __syncthreads();
        {
            LAS float* scr = (LAS float*)(lds + wid * 8704);
            constexpr int I_W1 = 16 * 128, I_W2 = 64 * 32, I_SQ = 16 * 32, I_QKV = 16 * 96, I_DOWN = 16 * 13, I_UQ = 4 * 48, I_UKV = 2 * 64;
            constexpr int NITEMS = 4 * I_W1 + 4 * I_W2 + 2 * I_SQ + I_QKV + I_SQ + I_DOWN + I_UQ + I_UKV + I_SQ;
            for (int it = gw; it < NITEMS; it += ngw) {
                int r = it;
                if (r < 4 * I_W1) { const int l = r / I_W1; transpose_item(a.in[9] + (size_t)l * D * DFF, D, DFF, W1T + (size_t)l * D * DFF, 0, nullptr, scr, r % I_W1, lane); continue; } r -= 4 * I_W1;
                if (r < 4 * I_W2) { const int l = r / I_W2; transpose_item(a.in[10] + (size_t)l * D * DFF, DFF, D, W2T + (size_t)l * D * DFF, 0, nullptr, scr, r % I_W2, lane); continue; } r -= 4 * I_W2;
                if (r < 2 * I_SQ) { const int l = r / I_SQ; transpose_item(a.in[11] + (size_t)l * D * D, D, D, FWT + (size_t)l * D * D, 2, nullptr, scr, r % I_SQ, lane); continue; } r -= 2 * I_SQ;
                if (r < I_QKV) { transpose_item(a.in[13], D, 3 * D, DQKV, 0, nullptr, scr, r, lane); continue; } r -= I_QKV;
                if (r < I_SQ) { transpose_item(a.in[19], D, D, DWO, 0, nullptr, scr, r, lane); continue; } r -= I_SQ;
                if (r < I_DOWN) { transpose_item(a.in[20], D, 416, MDOWN, 0, nullptr, scr, r, lane); continue; } r -= I_DOWN;
                if (r < I_UQ) { transpose_item(a.in[23], 256, 1536, MUQ, 0, a.in[21], scr, r, lane); continue; } r -= I_UQ;
                if (r < I_UKV) { transpose_item(a.in[24], 128, 2048, MUKV, 1, a.in[22], scr, r, lane); continue; } r -= I_UKV;
                transpose_item(a.in[25], D, D, MWO, 0, nullptr, scr, r, lane);
            }
        }
        for (size_t i = gtid; i < (size_t)96 * 1024 / 8; i += gthreads) *(u32x4*)(MDOWN + (size_t)416 * 1024 + i * 8) = (u32x4){0u, 0u, 0u, 0u};
        for (size_t i = gtid; i < (size_t)NTOK * 2 / 4; i += gthreads) *(f32x4*)(SSQ + i * 4) = (f32x4){0.f, 0.f, 0.f, 0.f};
        for (size_t chn = gtid; chn < (size_t)4096 * 2048 / 8; chn += gthreads) {
            const int r = (int)(chn >> 8), s0 = (int)(chn & 255) * 8; const bool sinb = r >= 2048; const int k = r & 2047; float v[8];
#pragma unroll
            for (int j = 0; j < 8; ++j) { const float rev = (float)((k * (s0 + j)) & 4095) * (1.f / 4096.f); v[j] = sinb ? __builtin_amdgcn_sinf(rev) : __builtin_amdgcn_cosf(rev); }
            u32x4 w; w.x = pk2(v[0], v[1]); w.y = pk2(v[2], v[3]); w.z = pk2(v[4], v[5]); w.w = pk2(v[6], v[7]);
            *(u32x4*)(DFT4K + (size_t)r * 2048 + s0) = w;
        }
        for (size_t i = gtid; i < (size_t)BATCH * D; i += gthreads) NYQ[i] = 0.f;
        for (size_t chn = gtid; chn < (size_t)512 * 256 / 8; chn += gthreads) {
            const int r = (int)(chn >> 5), s0 = (int)(chn & 31) * 8, k = r & 255, part = r >> 8; float v[8];
#pragma unroll
            for (int j = 0; j < 8; ++j) { const float rev = (float)((k * (s0 + j)) & 255) * (1.f / 256.f); v[j] = part ? __builtin_amdgcn_sinf(rev) : __builtin_amdgcn_cosf(rev); }
            u32x4 w; w.x = pk2(v[0], v[1]); w.y = pk2(v[2], v[3]); w.z = pk2(v[4], v[5]); w.w = pk2(v[6], v[7]);
            *(u32x4*)(DFT256 + (size_t)r * 256 + s0) = w;
        }
        if (blockIdx.x == (unsigned)(G - 1)) {
            for (int i = tid; i < 1024; i += 512) { const int p = i >> 4, f = i & 15; const float inv = exp2f(-(float)f * (13.287712379549449f / 16.f));
                const float rev = ((float)p * inv) * 0.15915494309189535f; ropeDc[i] = __builtin_amdgcn_cosf(rev); ropeDs[i] = __builtin_amdgcn_sinf(rev); }
            { const int i = tid; const int p = i >> 3, f = i & 7; const float inv = exp2f(-(float)f * (13.287712379549449f / 8.f));
                const float rev = ((float)p * inv) * 0.15915494309189535f; ropeMc[i] = __builtin_amdgcn_cosf(rev); ropeMs[i] = __builtin_amdgcn_sinf(rev); }
            if (tid == 0) { float s1 = 0.f, s2 = 0.f; for (int i = 0; i < 64; ++i) { s1 += a.in[14][i] * a.in[15][i]; s2 += a.in[16][i] * a.in[17][i]; }
                lamp[0] = expf(s1) - expf(s2) + LAM_INIT; }
        }
    }
    cg::this_grid().sync();
    const XcdBarrier xbar = xcd_barrier_post(BARW, (volatile LAS unsigned*)(lds + LDS_BYTES - 16));

    { EpiFw E{FMW}; GEMM_CALL(EpiFw, FWT, DFT256, 8192, 512, 256, 256, 256, 0, E); }

#pragma unroll 1
    for (int l = 0; l < DEPTH; ++l) {
        const int kind = l % 3; const bool wctx = l < DEPTH - 1; const int nrows = wctx ? NTOK : NLAT;
        const float* MODl = MOD + (size_t)l * NB * MODROW;
        const float* xl = (l == 0) ? x_in : out; const float* xc = (l == 0) ? ctx_in : XC;
        if (kind == 0) norm_rows_T(lds, xl, xc, nrows, norm_mix_g + l * D, MODl, 0, 1024, H, HN, NYQ);
        else norm_rows(xl, xc, nrows, norm_mix_g + l * D, MODl, 0, 1024, H, PART, XC);
        xcd_barrier(xbar);
        const bf16_t* Afin; const bf16_t* Wfin; int Kfin; const float* biasfin = nullptr;
        if (kind == 0) {
            const int j = l / 3;
            { const int ftid = fresh_tid();
              for (int i = blockIdx.x * 512 + ftid; i < BATCH * D; i += G * 512) { const int bb = i >> 10, d = i & 1023;
                  BIG[(size_t)(bb * SEQ + SEQ / 2) * 2048 + d] = f2bf(NYQ[i] + HN[i]); NYQ[i] = 0.f; } }
#pragma unroll 1
            for (int pass = 0; pass < (wctx ? 3 : 2); ++pass) {
                const bool cx = pass == 2; const int S_ = cx ? CTX : SEQ;
                EpiDft E{BIG, S_, cx ? 8 : 12, cx ? NLAT : 0, cx ? 0 : pass + 1, HN};
                const bf16_t* A_ = cx ? DFT256 : DFT4K + (size_t)pass * 2048 * 2048;
                const bf16_t* B_ = cx ? H + (size_t)NLAT * D : H + (size_t)pass * BATCH * D * 2048;
                const int M_ = cx ? 2 * CTX : 2048, K_ = cx ? CTX : 2048;
                GEMM_CALL(EpiDft, A_, B_, M_, 16384, K_, K_, K_, 0, E);
            }
            xcd_barrier(xbar);
            Afin = BIG; Wfin = FMW + (size_t)j * 1024 * 2048; Kfin = 2048; biasfin = a.in[12] + j * D;
        } else if (kind == 1) {
            bf16_t* Qb = BIG; bf16_t* Kb = BIG + (size_t)NTOK * D; bf16_t* VT = BIG + (size_t)2 * NTOK * D;
            { EpiDiffQK E{Qb, Kb, ropeDc, ropeDs, 0.125f * LOG2E}; GEMM_CALL(EpiDiffQK, H, DQKV, nrows, 2048, 1024, 1024, 1024, 0, E); }
            { EpiVt E{VT, nullptr}; GEMM_CALL(EpiVt, DQKV + (size_t)2048 * D, H, 1024, nrows, 1024, 1024, 1024, 128, E); }
            xcd_barrier(xbar);
            { const float lam = lamp[0]; const int nlat_u = BATCH * 8 * 32, nctx_u = wctx ? BATCH * 8 * 2 : 0;
              for (int u = blockIdx.x; u < nlat_u + nctx_u; u += G) {
                  int qrow0, b, h, nt;
                  if (u < nlat_u) { int qb = u & 31, bh = u >> 5;
                      if (G == 256) { const int it = u >> 8; bh = it * 8 + (blockIdx.x & 7); qb = blockIdx.x >> 3; }
                      b = bh >> 3; h = bh & 7; qrow0 = b * SEQ + qb * 128; nt = KVLEN / 64; }
                  else { const int uu = u - nlat_u, qb = uu & 1, bh = uu >> 1; b = bh >> 3; h = bh & 7; qrow0 = NLAT + b * CTX + qb * 128; nt = CTX / 64; }
                  attn_diff_unit(lds, Qb, Kb, VT, H, qrow0, b, h, nt, lam, a.in[18]);
              } }
            xcd_barrier(xbar);
            Afin = H; Wfin = DWO; Kfin = 1024;
        } else {
            bf16_t* QM = BIG; bf16_t* Kb = BIG + (size_t)NTOK * 1536; bf16_t* VT = Kb + (size_t)NTOK * D;
            { EpiMlaDown E{CQ, KR, SSQ, ropeMc, ropeMs}; GEMM_CALL(EpiMlaDown, H, MDOWN, nrows, 512, 1024, 1024, 1024, 0, E); }
            xcd_barrier(xbar);
            { EpiMlaQ E{QM, SSQ, ropeMc, ropeMs, 0.10206207261596577f * LOG2E}; GEMM_CALL(EpiMlaQ, CQ, MUQ, nrows, 1536, 256, 512, 256, 0, E); }
            { EpiMlaK E{Kb, SSQ}; GEMM_CALL(EpiMlaK, CQ + 256, MUKV, nrows, 1024, 128, 512, 128, 96, E); }
            { EpiVt E{VT, SSQ}; GEMM_CALL(EpiVt, MUKV + (size_t)1024 * 128, CQ + 256, 1024, nrows, 128, 128, 512, 160, E); }
            xcd_barrier(xbar);
            { const int nlat_u = BATCH * 16 * 16, nctx_u = wctx ? BATCH * 16 : 0;
              for (int u = blockIdx.x; u < nlat_u + nctx_u; u += G) {
                  int qrow0, b, h, nt;
                  if (u < nlat_u) { int qb = u & 15, bh = u >> 4;
                      if (G == 256) { const int it = u >> 8, sl = blockIdx.x >> 3; bh = (it * 8 + (blockIdx.x & 7)) * 2 + (sl >> 4); qb = sl & 15; }
                      b = bh >> 4; h = bh & 15; qrow0 = b * SEQ + qb * 256; nt = KVLEN / 64; }
                  else { const int bh = u - nlat_u; b = bh >> 4; h = bh & 15; qrow0 = NLAT + b * CTX; nt = CTX / 64; }
                  attn_mla_unit(lds, QM, Kb, KR, VT, H, qrow0, b, h, nt);
              } }
            xcd_barrier(xbar);
            Afin = H; Wfin = MWO; Kfin = 1024;
        }
        { EpiResid E{xl, xc, out, XC, MODl + 2048, biasfin}; GEMM_CALL(EpiResid, Afin, Wfin, NLAT, 1024, Kfin, Kfin, Kfin, 0, E); }
        if (wctx) {
            { EpiResidPart E{PART, MODl + 2048, biasfin};
              pg8::Gemm gg__{Afin + (size_t)NLAT * Kfin, Wfin, 4 * NCTX, 1024, Kfin / 4, Kfin, Kfin}; pg8::PartOrder so__; so__.init(4 * NCTX, 1024, G, (int)blockIdx.x);
              pg8::gemm_phase<EpiResidPart, pg8::PartOrder, true, true>(lds, gg__, so__, E); }
        }
        xcd_barrier(xbar);
        norm_rows(out, xc, nrows, norm_mlp_g + l * D, MODl, 3072, 4096, H, wctx ? PART : nullptr, XC);
        xcd_barrier(xbar);
        { EpiRelu2 E{BIG, DFF}; GEMM_CALL(EpiRelu2, H, W1T + (size_t)l * D * DFF, nrows, DFF, 1024, 1024, 1024, 0, E); }
        xcd_barrier(xbar);
        { EpiResid E{out, XC, out, XC, MODl + 5120, nullptr}; GEMM_CALL(EpiResid, BIG, W2T + (size_t)l * D * DFF, NLAT, 1024, DFF, DFF, DFF, 0, E); }
        if (wctx) {
            { EpiResidPart E{PART, MODl + 5120, nullptr};
              pg8::Gemm gg__{BIG + (size_t)NLAT * DFF, W2T + (size_t)l * D * DFF, 4 * NCTX, 1024, DFF / 4, DFF, DFF}; pg8::PartOrder so__; so__.init(4 * NCTX, 1024, G, (int)blockIdx.x);
              pg8::gemm_phase<EpiResidPart, pg8::PartOrder, true, true>(lds, gg__, so__, E); }
        }
        xcd_barrier(xbar);
    }
    const int ftid = fresh_tid(), lane = ftid & 63, gw = blockIdx.x * NWAVES + __builtin_amdgcn_readfirstlane(ftid >> 6), ngw = G * NWAVES;
    for (int row_ = gw; row_ < NLAT; row_ += ngw) { const int row = NLAT - 1 - row_;
        float* xp = out + (size_t)row * D; f32x4 v[4]; float ss = 0.f;
#pragma unroll
        for (int j = 0; j < 4; ++j) { v[j] = *(const f32x4*)(xp + j * 256 + lane * 4); ss += dot4(v[j]); }
        ss = wave_sum(ss); const float rstd = rsqrtf(ss * (1.f / 1024.f) + EPS);
#pragma unroll
        for (int j = 0; j < 4; ++j) { const f32x4 gv = *(const f32x4*)(final_g + j * 256 + lane * 4); *(f32x4*)(xp + j * 256 + lane * 4) = v[j] * rstd * gv; }
    }
}
}

extern "C" void kernel_launch(void* const* d_in, const int* in_sizes, int n_in, void* d_out, int out_size, void* d_ws, size_t ws_size, hipStream_t stream) {
    constexpr size_t kDynLds = mk::LDS_BYTES;
    static int grid_blocks = 0;
    if (!grid_blocks) {
        int dev = 0, cus = 0, per_cu = 0;
        (void)hipGetDevice(&dev);
        (void)hipDeviceGetAttribute(&cus, hipDeviceAttributeMultiprocessorCount, dev);
        (void)hipFuncSetAttribute((const void*)mk::fwd_megakernel, hipFuncAttributeMaxDynamicSharedMemorySize, (int)kDynLds);
        (void)hipOccupancyMaxActiveBlocksPerMultiprocessor(&per_cu, (const void*)mk::fwd_megakernel, 512, kDynLds);
        if (per_cu < 1) per_cu = 1;
        grid_blocks = cus * per_cu;
        if (n_in != 26 || ws_size < mk::WS_END) fprintf(stderr, "kernel_launch: unexpected n_in %d / ws_size %zu\n", n_in, ws_size);
    }
    mk::Args a{};
    for (int i = 0; i < 26; ++i) a.in[i] = (const float*)d_in[i];
    a.out = (float*)d_out; a.ws = (unsigned char*)d_ws;
    void* args[] = {&a};
    hipError_t e = hipLaunchCooperativeKernel((const void*)mk::fwd_megakernel, dim3(grid_blocks), dim3(512), args, kDynLds, stream);
    if (e != hipSuccess) fprintf(stderr, "cooperative launch failed: %s (grid %d)\n", hipGetErrorString(e), grid_blocks);
}
```
